# Optimizing an MI355X kernel written in HIP

```python
import math
import jax
import jax.numpy as jnp
from jax import lax
import numpy as np


D_MODEL = 1024
BATCH = 8
SEQ = 4096
DEPTH = 2

CTX_LEN = 256
GRID_W = 64
NA_HEADS = 8
NA_HEAD_DIM = 64
NA_WIDTH = NA_HEADS * NA_HEAD_DIM
NA_WIN_ROWS = 8
NA_WIN_COLS = 16
SSM_HEADS = 16
SSM_HEAD_DIM = 64
SSM_INNER = SSM_HEADS * SSM_HEAD_DIM
SSM_GROUPS = 4
SSM_STATE = 128
SSM_CONV = 3
SSD_CHUNK = 128
SSM_CONV_DIM = SSM_INNER + 2 * SSM_GROUPS * SSM_STATE
DT_MIN = 0.001
DT_MAX = 0.1
POOL_WINDOWS = (2, 4, 8, 16)
N_POOL = len(POOL_WINDOWS)
POOL_GROUP = D_MODEL // N_POOL
FFN_HIDDEN = 2816
FFN_CONV = 3
RMS_EPS = 1e-6
N_EVEN = (DEPTH + 1) // 2
N_ODD = DEPTH // 2
IN_SPLITS = (NA_WIDTH, SSM_INNER, NA_WIDTH, NA_WIDTH, SSM_CONV_DIM, 2 * SSM_HEADS)
IN_WIDTH = sum(IN_SPLITS)
CTX_KV_OFFSET = NA_WIDTH + SSM_INNER
MIX_WIDTH = NA_WIDTH + SSM_INNER

kernel_name = "hybrid_natten_ssd_pool_dit_block"


def rmsnorm(x, g):
    xf = x.astype(jnp.float32)
    xf = xf * lax.rsqrt(jnp.mean(xf * xf, axis=-1, keepdims=True) + RMS_EPS)
    return xf.astype(x.dtype) * g


def modulate(h, shift, scale):
    return h * (1 + scale) + shift


def split_cols(p, sizes):
    return jnp.split(p, [int(v) for v in np.cumsum(sizes)[:-1]], axis=-1)


def dwconv_centred(x, w, b):
    k = w.shape[0]
    pad = k // 2
    l = x.shape[1]
    xp = jnp.pad(x, ((0, 0), (pad, pad), (0, 0)))
    return sum(xp[:, j:j + l] * w[j] for j in range(k)) + b


def neighbourhood_attention(q, k, v, kc, vc, rpb):
    bsz, s, h, dh = q.shape
    rows = s // GRID_W
    kh = min(NA_WIN_ROWS, rows)
    kw = NA_WIN_COLS
    scale = dh ** -0.5
    qg = q.reshape(bsz, rows, GRID_W, h, dh)
    kg = k.reshape(bsz, rows, GRID_W, h, dh)
    vg = v.reshape(bsz, rows, GRID_W, h, dh)
    cols = jnp.arange(GRID_W)
    col_idx = jnp.clip(cols - kw // 2, 0, GRID_W - kw)[:, None] + jnp.arange(kw)
    rel_col = col_idx - cols[:, None] + (NA_WIN_COLS - 1)

    def row_block(r):
        rs = jnp.clip(r - kh // 2, 0, rows - kh)
        q_r = lax.dynamic_index_in_dim(qg, r, axis=1, keepdims=False)
        k_win = lax.dynamic_slice_in_dim(kg, rs, kh, axis=1)[:, :, col_idx]
        v_win = lax.dynamic_slice_in_dim(vg, rs, kh, axis=1)[:, :, col_idx]
        rel_row = rs + jnp.arange(kh) - r + (NA_WIN_ROWS - 1)
        bias = rpb[:, rel_row[None, :, None], rel_col[:, None, :]]
        s_lat = jnp.einsum('bqhd,biqjhd->bhqij', q_r, k_win).astype(jnp.float32) * scale + bias.astype(jnp.float32)
        s_ctx = jnp.einsum('bqhd,blhd->bhql', q_r, kc).astype(jnp.float32) * scale
        p = jax.nn.softmax(jnp.concatenate([s_lat.reshape(bsz, h, GRID_W, kh * kw), s_ctx], axis=-1), axis=-1).astype(v.dtype)
        p_lat = p[..., :kh * kw].reshape(bsz, h, GRID_W, kh, kw)
        p_ctx = p[..., kh * kw:]
        return jnp.einsum('bhqij,biqjhd->bqhd', p_lat, v_win) + jnp.einsum('bhql,blhd->bqhd', p_ctx, vc)

    out = lax.map(row_block, jnp.arange(rows))
    return out.transpose(1, 0, 2, 3, 4).reshape(bsz, s, h * dh)


def context_attention(qc, kc, vc):
    bsz, l, h, dh = qc.shape
    s = jnp.einsum('blhd,bmhd->bhlm', qc, kc).astype(jnp.float32) * dh ** -0.5
    p = jax.nn.softmax(s, axis=-1).astype(vc.dtype)
    return jnp.einsum('bhlm,bmhd->blhd', p, vc).reshape(bsz, l, h * dh)


def ssd_scan(x, a, bm, cm, h0):
    bsz, l, h, p = x.shape
    g, n = bm.shape[-2:]
    r = h // g
    q = SSD_CHUNK
    nc = l // q
    dtype = x.dtype
    xc = x.reshape(bsz, nc, q, g, r, p)
    bc = bm.reshape(bsz, nc, q, g, n)
    cc = cm.reshape(bsz, nc, q, g, n)
    a_cs = jnp.cumsum(a.astype(jnp.float32).reshape(bsz, nc, q, g, r).transpose(0, 3, 4, 1, 2), axis=-1)
    lower = jnp.tril(jnp.ones((q, q), dtype=bool))
    seg = jnp.exp(jnp.where(lower, a_cs[..., :, None] - a_cs[..., None, :], -jnp.inf)).astype(dtype)
    cb = jnp.einsum('bclgn,bcsgn->bcgls', cc, bc)
    y_diag = jnp.einsum('bcgls,bgrcls,bcsgrp->bclgrp', cb, seg, xc)
    to_end = jnp.exp(a_cs[..., -1:] - a_cs).astype(dtype)
    chunk_states = jnp.einsum('bcsgn,bgrcs,bcsgrp->cbgrpn', bc, to_end, xc)
    chunk_decay = jnp.exp(a_cs[..., -1]).astype(dtype).transpose(3, 0, 1, 2)

    def step(state, inp):
        s_c, dec = inp
        return state * dec[..., None, None] + s_c, state

    h_final, h_in = lax.scan(step, h0.astype(dtype), (chunk_states, chunk_decay))
    from_start = jnp.exp(a_cs).astype(dtype)
    y_off = jnp.einsum('bclgn,cbgrpn,bgrcl->bclgrp', cc, h_in, from_start)
    return (y_diag + y_off).reshape(bsz, l, h, p), h_final


def bidirectional_ssd(xbc, dtr, xbc_c, dtr_c, a_log, dt_bias, d_skip):
    def parts(t):
        xs, bm, cm = split_cols(t, (SSM_INNER, SSM_GROUPS * SSM_STATE, SSM_GROUPS * SSM_STATE))
        b_, l_ = t.shape[:2]
        return (xs.reshape(b_, l_, SSM_HEADS, SSM_HEAD_DIM),
                bm.reshape(b_, l_, SSM_GROUPS, SSM_STATE),
                cm.reshape(b_, l_, SSM_GROUPS, SSM_STATE))

    lat = parts(xbc)
    ctxp = parts(xbc_c)
    h_zero = jnp.zeros((xbc_c.shape[0], SSM_GROUPS, SSM_HEADS // SSM_GROUPS, SSM_HEAD_DIM, SSM_STATE), xbc.dtype)

    def run(pp, dt_raw, h0, d):
        xs, bm, cm = pp
        dt = jax.nn.softplus(dt_raw[:, :, d].astype(jnp.float32) + dt_bias[d].astype(jnp.float32))
        a = -dt * jnp.exp(a_log[d].astype(jnp.float32))
        xdt = xs * dt[..., None].astype(xs.dtype)
        order = (lambda t: jnp.flip(t, axis=1)) if d == 1 else (lambda t: t)
        y, h_last = ssd_scan(order(xdt), order(a), order(bm), order(cm), h0)
        return order(y) + d_skip[d][:, None] * xs, h_last

    y_lat = 0
    y_ctx = 0
    for d in range(2):
        yc, h_ctx = run(ctxp, dtr_c, h_zero, d)
        yl, _ = run(lat, dtr, h_ctx, d)
        y_lat = y_lat + yl
        y_ctx = y_ctx + yc
    return y_lat, y_ctx


def gated_rmsnorm(y, z, g):
    yz = (y * jax.nn.silu(z)).astype(jnp.float32)
    shp = yz.shape
    yz = yz.reshape(shp[:-1] + (SSM_GROUPS, shp[-1] // SSM_GROUPS))
    yz = yz * lax.rsqrt(jnp.mean(yz * yz, axis=-1, keepdims=True) + RMS_EPS)
    return yz.reshape(shp).astype(y.dtype) * g


def attn_ssd_mixer(h, hc, w_in, w_out, rpb, conv_w, conv_b, a_log, dt_bias, d_skip, norm_g, ctx_out):
    bsz, s, _ = h.shape
    l = hc.shape[1]
    heads = lambda t: t.reshape(t.shape[0], t.shape[1], NA_HEADS, NA_HEAD_DIM)
    q, z, k, v, xbc, dtr = split_cols(h @ w_in, IN_SPLITS)
    if ctx_out:
        qc, zc, kc, vc, xbc_c, dtr_c = split_cols(hc @ w_in, IN_SPLITS)
    else:
        kc, vc, xbc_c, dtr_c = split_cols(hc @ w_in[:, CTX_KV_OFFSET:], IN_SPLITS[2:])
    att = neighbourhood_attention(heads(q), heads(k), heads(v), heads(kc), heads(vc), rpb)
    xbc = jax.nn.silu(dwconv_centred(xbc, conv_w, conv_b))
    xbc_c = jax.nn.silu(dwconv_centred(xbc_c, conv_w, conv_b))
    y_ssm, y_ssm_c = bidirectional_ssd(xbc, dtr.reshape(bsz, s, 2, SSM_HEADS), xbc_c,
                                       dtr_c.reshape(bsz, l, 2, SSM_HEADS), a_log, dt_bias, d_skip)
    ssm = gated_rmsnorm(y_ssm.reshape(bsz, s, SSM_INNER), z, norm_g)
    y = jnp.concatenate([att, ssm], axis=-1) @ w_out
    if not ctx_out:
        return y, None
    att_c = context_attention(heads(qc), heads(kc), heads(vc))
    ssm_c = gated_rmsnorm(y_ssm_c.reshape(bsz, l, SSM_INNER), zc, norm_g)
    return y, jnp.concatenate([att_c, ssm_c], axis=-1) @ w_out


def multiscale_pool_mixer(h, pool_w, pool_b, pool_scale):
    bsz, l, d = h.shape
    hf = h.astype(jnp.float32)
    cs = jnp.concatenate([jnp.zeros((bsz, 1, d), jnp.float32), jnp.cumsum(hf, axis=1)], axis=1)
    t = jnp.arange(l)
    outs = []
    for gi, w in enumerate(POOL_WINDOWS):
        lo = jnp.clip(t - w // 2, 0, l)
        hi = jnp.clip(t - w // 2 + w, 0, l)
        sl = slice(gi * POOL_GROUP, (gi + 1) * POOL_GROUP)
        csg = cs[..., sl]
        mean = (csg[:, hi] - csg[:, lo]) / (hi - lo).astype(jnp.float32)[:, None]
        outs.append(mean - hf[..., sl])
    pooled = jnp.stack(outs, axis=2).astype(h.dtype)
    y = jnp.einsum('blgc,gcd->blgd', pooled, pool_w) + pool_b
    return y.reshape(bsz, l, d) * pool_scale


def conv_ffn(h, w_up, conv_w, conv_b, w_down):
    u, v = jnp.split(h @ w_up, 2, axis=-1)
    return (jax.nn.gelu(dwconv_centred(u, conv_w, conv_b), approximate=False) * v) @ w_down


def setup_inputs(seed: int = 0) -> dict:
    key = jax.random.key(seed)
    ks = jax.random.split(key, 24)
    f32 = jnp.float32

    def nrm(k, shape, s):
        return jax.random.normal(k, shape, f32) * s

    dt0 = jnp.exp(jax.random.uniform(ks[13], (N_EVEN, 2, SSM_HEADS), f32, math.log(DT_MIN), math.log(DT_MAX)))
    return {
        'x': nrm(ks[0], (BATCH, SEQ, D_MODEL), 1.0),
        'c': nrm(ks[1], (BATCH, D_MODEL), 1.0),
        'ctx': nrm(ks[2], (BATCH, CTX_LEN, D_MODEL), 1.0),
        'c_ctx': nrm(ks[3], (D_MODEL,), 1.0),
        'ada_w': nrm(ks[4], (DEPTH, D_MODEL, 6 * D_MODEL), D_MODEL ** -0.5),
        'ada_b': nrm(ks[5], (DEPTH, 6 * D_MODEL), 0.01),
        'norm_g': 1.0 + nrm(ks[6], (DEPTH, 4, D_MODEL), 0.05),
        'w_in': nrm(ks[7], (N_EVEN, D_MODEL, IN_WIDTH), D_MODEL ** -0.5),
        'w_out': nrm(ks[8], (N_EVEN, MIX_WIDTH, D_MODEL), MIX_WIDTH ** -0.5),
        'na_rpb': nrm(ks[9], (N_EVEN, NA_HEADS, 2 * NA_WIN_ROWS - 1, 2 * NA_WIN_COLS - 1), 0.1),
        'ssm_conv_w': nrm(ks[10], (N_EVEN, SSM_CONV, SSM_CONV_DIM), SSM_CONV ** -0.5),
        'ssm_conv_b': nrm(ks[11], (N_EVEN, SSM_CONV_DIM), 0.01),
        'ssm_a_log': jnp.log(jax.random.uniform(ks[12], (N_EVEN, 2, SSM_HEADS), f32, 1.0, 16.0)),
        'ssm_dt_bias': dt0 + jnp.log(-jnp.expm1(-dt0)),
        'ssm_d': 1.0 + nrm(ks[14], (N_EVEN, 2, SSM_HEADS), 0.1),
        'ssm_norm_g': 1.0 + nrm(ks[15], (N_EVEN, SSM_INNER), 0.05),
        'pool_w': nrm(ks[16], (N_ODD, N_POOL, POOL_GROUP, POOL_GROUP), POOL_GROUP ** -0.5),
        'pool_b': nrm(ks[17], (N_ODD, N_POOL, POOL_GROUP), 0.01),
        'pool_scale': 1.0 + nrm(ks[18], (N_ODD, D_MODEL), 0.1),
        'ffn_w_up': nrm(ks[19], (DEPTH, D_MODEL, 2 * FFN_HIDDEN), D_MODEL ** -0.5),
        'ffn_conv_w': nrm(ks[20], (DEPTH, FFN_CONV, FFN_HIDDEN), FFN_CONV ** -0.5),
        'ffn_conv_b': nrm(ks[21], (DEPTH, FFN_HIDDEN), 0.01),
        'ffn_w_down': nrm(ks[22], (DEPTH, FFN_HIDDEN, D_MODEL), FFN_HIDDEN ** -0.5),
    }


def reference(x, c, ctx, c_ctx, ada_w, ada_b, norm_g, w_in, w_out, na_rpb, ssm_conv_w, ssm_conv_b,
              ssm_a_log, ssm_dt_bias, ssm_d, ssm_norm_g, pool_w, pool_b, pool_scale,
              ffn_w_up, ffn_conv_w, ffn_conv_b, ffn_w_down):
    xc = ctx
    for i in range(DEPTH):
        ctx_live = any(j % 2 == 0 for j in range(i + 1, DEPTH))
        m = (jax.nn.silu(c) @ ada_w[i] + ada_b[i])[:, None, :]
        sh1, sc1, g1, sh2, sc2, g2 = jnp.split(m, 6, axis=-1)
        mc = jax.nn.silu(c_ctx) @ ada_w[i] + ada_b[i]
        csh1, csc1, cg1, csh2, csc2, cg2 = jnp.split(mc, 6, axis=-1)
        g_pre_mix, g_post_mix, g_pre_ffn, g_post_ffn = norm_g[i]

        h = modulate(rmsnorm(x, g_pre_mix), sh1, sc1)
        if i % 2 == 0:
            e = i // 2
            hc = modulate(rmsnorm(xc, g_pre_mix), csh1, csc1)
            y, yc = attn_ssd_mixer(h, hc, w_in[e], w_out[e], na_rpb[e], ssm_conv_w[e], ssm_conv_b[e],
                                   ssm_a_log[e], ssm_dt_bias[e], ssm_d[e], ssm_norm_g[e], ctx_live)
        else:
            o = i // 2
            y = multiscale_pool_mixer(h, pool_w[o], pool_b[o], pool_scale[o])
            yc = None
            if ctx_live:
                hc = modulate(rmsnorm(xc, g_pre_mix), csh1, csc1)
                yc = multiscale_pool_mixer(hc, pool_w[o], pool_b[o], pool_scale[o])
        x = x + g1 * rmsnorm(y, g_post_mix)
        hf = modulate(rmsnorm(x, g_pre_ffn), sh2, sc2)
        x = x + g2 * rmsnorm(conv_ffn(hf, ffn_w_up[i], ffn_conv_w[i], ffn_conv_b[i], ffn_w_down[i]), g_post_ffn)
        if ctx_live:
            xc = xc + cg1 * rmsnorm(yc, g_post_mix)
            hfc = modulate(rmsnorm(xc, g_pre_ffn), csh2, csc2)
            xc = xc + cg2 * rmsnorm(conv_ffn(hfc, ffn_w_up[i], ffn_conv_w[i], ffn_conv_b[i], ffn_w_down[i]), g_post_ffn)
    return x
```

```cpp
#include <hip/hip_runtime.h>
#include <hip/hip_cooperative_groups.h>
#include <cstdio>
namespace cg = cooperative_groups;

#ifndef MK_COOP
#define MK_COOP 0
#endif

#define DEV __device__ __forceinline__
typedef unsigned short u16;
typedef __attribute__((ext_vector_type(8))) short bf16x8;
typedef __attribute__((ext_vector_type(4))) float f32x4;

constexpr int D = 1024, NB = 8, SEQ = 4096, NTOK = NB * SEQ, CTXL = 256, NCTX = NB * CTXL;
constexpr int INW = 4640, INWP = 4736, MIXW = 1536, FFH = 2816, FFH2 = 5632;
constexpr int XBCW = 2048;
constexpr size_t MiB = 1u << 20;
constexpr size_t OFF_WIN = 0, OFF_WOUT = 10 * MiB, OFF_POOLT = 13 * MiB, OFF_MOD = 14 * MiB,
                 OFF_DTRAW = 15 * MiB, OFF_DTRAWC = 19 * MiB, OFF_SSQ = 20 * MiB, OFF_CNT = 22 * MiB,
                 OFF_KC = 24 * MiB, OFF_VC = 26 * MiB, OFF_XBCC = 28 * MiB, OFF_HA = 36 * MiB,
                 OFF_Y1 = OFF_HA, OFF_HC = 100 * MiB, OFF_QB = 104 * MiB, OFF_Y0 = 136 * MiB,
                 OFF_ZB = 200 * MiB, OFF_YBUF = OFF_ZB, OFF_KB = 264 * MiB, OFF_VB = 296 * MiB,
                 OFF_WUP = 264 * MiB, OFF_WDOWN = 286 * MiB, OFF_XBC = 328 * MiB, OFF_VT = 456 * MiB,
                 OFF_HALO = 488 * MiB, OFF_UV = 328 * MiB, OFF_GACT = 104 * MiB, OFF_POOLED = 104 * MiB;
constexpr size_t WUP_SZ = (size_t)FFH2 * D * 2, WDOWN_SZ = (size_t)D * FFH * 2;

struct Params {
  const float *x, *c, *ctx, *c_ctx, *ada_w, *ada_b, *norm_g, *w_in, *w_out, *na_rpb, *conv_w, *conv_b,
      *a_log, *dt_bias, *ssm_d, *ssm_norm_g, *pool_w, *pool_b, *pool_scale, *w_up, *fconv_w, *fconv_b, *w_down;
  float* out;
  char* ws;
};

DEV u16 f2bf(float f) {
  unsigned u = __float_as_uint(f);
  u += 0x7fffu + ((u >> 16) & 1u);
  return (u16)(u >> 16);
}
DEV float bf2f(u16 h) { return __uint_as_float(((unsigned)h) << 16); }
DEV unsigned pack2(float a, float b) { return (unsigned)f2bf(a) | ((unsigned)f2bf(b) << 16); }
DEV float lo2f(unsigned u) { return __uint_as_float(u << 16); }
DEV float hi2f(unsigned u) { return __uint_as_float(u & 0xffff0000u); }
DEV float wave_sum(float v) {
#pragma unroll
  for (int o = 32; o > 0; o >>= 1) v += __shfl_xor(v, o);
  return v;
}
DEV float wave_max(float v) {
#pragma unroll
  for (int o = 32; o > 0; o >>= 1) v = fmaxf(v, __shfl_xor(v, o));
  return v;
}
DEV float silu_f(float v) { return v / (1.f + __expf(-v)); }
DEV float softplus_f(float v) { return v > 20.f ? v : log1pf(__expf(v)); }
DEV void unpack8(const uint4& u, float* f) {
  f[0] = lo2f(u.x); f[1] = hi2f(u.x); f[2] = lo2f(u.y); f[3] = hi2f(u.y);
  f[4] = lo2f(u.z); f[5] = hi2f(u.z); f[6] = lo2f(u.w); f[7] = hi2f(u.w);
}
DEV uint4 pack8(const float* f) {
  uint4 u;
  u.x = pack2(f[0], f[1]); u.y = pack2(f[2], f[3]); u.z = pack2(f[4], f[5]); u.w = pack2(f[6], f[7]);
  return u;
}

struct SrcPlain {
  const u16* base; int ld;
  DEV uint4 load(int row, int k) const { return *(const uint4*)(base + (size_t)row * ld + k); }
};
struct SrcCat {
  const u16* a; int lda; int ka; const u16* b; int ldb;
  DEV uint4 load(int row, int k) const {
    return k < ka ? *(const uint4*)(a + (size_t)row * lda + k) : *(const uint4*)(b + (size_t)row * ldb + (k - ka));
  }
};

template <bool SSQ, class PS, class QS, class Epi>
DEV void gemm_tile(const PS& ps, const QS& qs, int K, char* smem, Epi& epi) {
  const int tid = threadIdx.x, lane = tid & 63, wave = tid >> 6;
  const int wi = wave >> 1, wj = wave & 1, lr = lane & 15, lq = lane >> 4;
  f32x4 acc[4][4];
#pragma unroll
  for (int m = 0; m < 4; ++m)
#pragma unroll
    for (int n = 0; n < 4; ++n) acc[m][n] = f32x4{0.f, 0.f, 0.f, 0.f};
  const int srow = tid >> 3, sch = tid & 7;
  const int swz = ((sch ^ (srow & 7)) << 4);
  uint4 pr[4], qr[4];
  const int nk = K >> 6;
  __syncthreads();
#pragma unroll
  for (int s = 0; s < 4; ++s) { pr[s] = ps.load(srow + 32 * s, sch * 8); qr[s] = qs.load(srow + 32 * s, sch * 8); }
#pragma unroll
  for (int s = 0; s < 4; ++s) {
    *(uint4*)(smem + (srow + 32 * s) * 128 + swz) = pr[s];
    *(uint4*)(smem + 16384 + (srow + 32 * s) * 128 + swz) = qr[s];
  }
  __syncthreads();
  for (int kt = 0; kt < nk; ++kt) {
    const bool more = (kt + 1 < nk);
    if (more) {
#pragma unroll
      for (int s = 0; s < 4; ++s) {
        pr[s] = ps.load(srow + 32 * s, (kt + 1) * 64 + sch * 8);
        qr[s] = qs.load(srow + 32 * s, (kt + 1) * 64 + sch * 8);
      }
    }
    const char* pb = smem + (kt & 1) * 32768;
    const char* qb = pb + 16384;
#pragma unroll
    for (int ks = 0; ks < 2; ++ks) {
      bf16x8 a[4], b[4];
#pragma unroll
      for (int m = 0; m < 4; ++m) {
        const int row = wi * 64 + m * 16 + lr;
        a[m] = *(const bf16x8*)(pb + row * 128 + (((ks * 4 + lq) ^ (row & 7)) << 4));
      }
#pragma unroll
      for (int n = 0; n < 4; ++n) {
        const int row = wj * 64 + n * 16 + lr;
        b[n] = *(const bf16x8*)(qb + row * 128 + (((ks * 4 + lq) ^ (row & 7)) << 4));
      }
#pragma unroll
      for (int m = 0; m < 4; ++m)
#pragma unroll
        for (int n = 0; n < 4; ++n) acc[m][n] = __builtin_amdgcn_mfma_f32_16x16x32_bf16(a[m], b[n], acc[m][n], 0, 0, 0);
    }
    if (more) {
      char* nb = smem + ((kt + 1) & 1) * 32768;
#pragma unroll
      for (int s = 0; s < 4; ++s) {
        *(uint4*)(nb + (srow + 32 * s) * 128 + swz) = pr[s];
        *(uint4*)(nb + 16384 + (srow + 32 * s) * 128 + swz) = qr[s];
      }
    }
    __syncthreads();
  }
#pragma unroll
  for (int n = 0; n < 4; ++n) {
    const int j = wj * 64 + n * 16 + lr;
    float ss = 0.f;
#pragma unroll
    for (int m = 0; m < 4; ++m) {
      const int i = wi * 64 + m * 16 + lq * 4;
      f32x4 v = epi.store(i, j, acc[m][n]);
      if (SSQ) ss += v[0] * v[0] + v[1] * v[1] + v[2] * v[2] + v[3] * v[3];
    }
    if (SSQ) {
      ss += __shfl_xor(ss, 16);
      ss += __shfl_xor(ss, 32);
      if (lq == 0) epi.ssq(j, wi, ss);
    }
  }
}

DEV void convert_tile(const float* W, int K, int N, u16* WT, int kt, int nt, char* smem) {
  u16(*t)[72] = (u16(*)[72])smem;
  const int tid = threadIdx.x;
  __syncthreads();
#pragma unroll
  for (int s = 0; s < 4; ++s) {
    const int k = (tid >> 4) + 16 * s, n4 = (tid & 15) * 4;
    const int gn = nt * 64 + n4;
    float4 v = make_float4(0.f, 0.f, 0.f, 0.f);
    if (gn < N) v = *(const float4*)(W + (size_t)(kt * 64 + k) * N + gn);
    t[n4 + 0][k] = f2bf(v.x); t[n4 + 1][k] = f2bf(v.y); t[n4 + 2][k] = f2bf(v.z); t[n4 + 3][k] = f2bf(v.w);
  }
  __syncthreads();
#pragma unroll
  for (int s = 0; s < 2; ++s) {
    const int n = (tid >> 3) + 32 * s, k8 = (tid & 7) * 8;
    const int gn = nt * 64 + n;
    if (gn < N) *(uint4*)(WT + (size_t)gn * K + kt * 64 + k8) = *(const uint4*)(&t[n][k8]);
  }
}

DEV void phase_ada_item(const Params& p, int item, char* smem) {
  const int l = item / 48, cc = item % 48, tid = threadIdx.x;
  float* sc = (float*)smem;
  __syncthreads();
  for (int e = tid; e < 9 * 1024; e += 256) {
    const int r = e >> 10, k = e & 1023;
    const float v = r < 8 ? p.c[r * 1024 + k] : p.c_ctx[k];
    sc[e] = silu_f(v);
  }
  __syncthreads();
  const int kq = tid >> 5, l32 = tid & 31;
  const int n = cc * 128 + l32 * 4;
  float acc[9][4];
#pragma unroll
  for (int r = 0; r < 9; ++r)
#pragma unroll
    for (int q = 0; q < 4; ++q) acc[r][q] = 0.f;
  const float* W = p.ada_w + (size_t)l * 1024 * 6144 + n;
#pragma unroll 4
  for (int kk = 0; kk < 128; ++kk) {
    const int k = kq * 128 + kk;
    const float4 w = *(const float4*)(W + (size_t)k * 6144);
#pragma unroll
    for (int r = 0; r < 9; ++r) {
      const float s = sc[r * 1024 + k];
      acc[r][0] += s * w.x; acc[r][1] += s * w.y; acc[r][2] += s * w.z; acc[r][3] += s * w.w;
    }
  }
  __syncthreads();
  float* red = (float*)smem;
#pragma unroll
  for (int r = 0; r < 9; ++r)
#pragma unroll
    for (int q = 0; q < 4; ++q) red[(kq * 9 + r) * 128 + l32 * 4 + q] = acc[r][q];
  __syncthreads();
  float* mod = (float*)(p.ws + OFF_MOD);
  for (int e = tid; e < 9 * 128; e += 256) {
    const int r = e / 128, col = e % 128;
    float s = p.ada_b[l * 6144 + cc * 128 + col];
#pragma unroll
    for (int q = 0; q < 8; ++q) s += red[(q * 9 + r) * 128 + col];
    mod[((size_t)l * 9 + r) * 6144 + cc * 128 + col] = s;
  }
}

DEV void phase0(const Params& p, char* smem, int bid, int nblk) {
  constexpr int N_ADA = 96, N_WIN = 16 * 73, N_WOUT = 24 * 16, N_POOL = 64;
  const int total = N_ADA + N_WIN + N_WOUT + N_POOL + 1;
  for (int it = bid; it < total; it += nblk) {
    int id = it;
    if (id < N_ADA) { phase_ada_item(p, id, smem); continue; }
    id -= N_ADA;
    if (id < N_WIN) { convert_tile(p.w_in, 1024, INW, (u16*)(p.ws + OFF_WIN), id / 73, id % 73, smem); continue; }
    id -= N_WIN;
    if (id < N_WOUT) { convert_tile(p.w_out, MIXW, 1024, (u16*)(p.ws + OFF_WOUT), id / 16, id % 16, smem); continue; }
    id -= N_WOUT;
    if (id < N_POOL) {
      const int g = id / 16, r = id % 16;
      convert_tile(p.pool_w + (size_t)g * 65536, 256, 256, (u16*)(p.ws + OFF_POOLT) + (size_t)g * 65536, r / 4, r % 4, smem);
      continue;
    }
    uint4* z = (uint4*)((u16*)(p.ws + OFF_WIN) + (size_t)INW * 1024);
    for (int e = threadIdx.x; e < (INWP - INW) * 1024 / 8; e += 256) z[e] = make_uint4(0, 0, 0, 0);
  }
}

DEV void load_row16(const float* src, int lane, float* v) {
#pragma unroll
  for (int s = 0; s < 4; ++s) {
    const float4 t = *(const float4*)(src + lane * 4 + 256 * s);
    v[s * 4 + 0] = t.x; v[s * 4 + 1] = t.y; v[s * 4 + 2] = t.z; v[s * 4 + 3] = t.w;
  }
}
DEV void norm_mod_store(const float* v, float rstd, const float* g, const float* shift, const float* scale, u16* dst, int lane) {
#pragma unroll
  for (int s = 0; s < 4; ++s) {
    const int c = lane * 4 + 256 * s;
    const float4 gg = *(const float4*)(g + c), sh = *(const float4*)(shift + c), sc = *(const float4*)(scale + c);
    const float h0 = v[s * 4 + 0] * rstd * gg.x * (1.f + sc.x) + sh.x;
    const float h1 = v[s * 4 + 1] * rstd * gg.y * (1.f + sc.y) + sh.y;
    const float h2 = v[s * 4 + 2] * rstd * gg.z * (1.f + sc.z) + sh.z;
    const float h3 = v[s * 4 + 3] * rstd * gg.w * (1.f + sc.w) + sh.w;
    uint2 o; o.x = pack2(h0, h1); o.y = pack2(h2, h3);
    *(uint2*)(dst + c) = o;
  }
}

DEV void phase_norm_in(const Params& p, int bid, int nblk) {
  const int lane = threadIdx.x & 63, gw = bid * 4 + (threadIdx.x >> 6), nw = nblk * 4;
  const float* mod = (const float*)(p.ws + OFF_MOD);
  const float* g = p.norm_g;
  for (int row = gw; row < NTOK + NCTX; row += nw) {
    const bool isctx = row >= NTOK;
    const int r = isctx ? row - NTOK : row;
    const float* src = isctx ? p.ctx + (size_t)r * D : p.x + (size_t)r * D;
    const int b = isctx ? 8 : r / SEQ;
    float v[16];
    load_row16(src, lane, v);
    float ss = 0.f;
#pragma unroll
    for (int e = 0; e < 16; ++e) ss += v[e] * v[e];
    ss = wave_sum(ss);
    const float rstd = rsqrtf(ss * (1.f / D) + 1e-6f);
    const float* m = mod + (size_t)b * 6144;
    u16* dst = isctx ? (u16*)(p.ws + OFF_HC) + (size_t)r * D : (u16*)(p.ws + OFF_HA) + (size_t)r * D;
    norm_mod_store(v, rstd, g, m, m + 1024, dst, lane);
  }
}

DEV void phase_row_update(const Params& p, int bid, int nblk, const float* xin, float* xout, const float* gate_base,
                          const float* gpost, bool has_next, const float* gnext, const float* shift_base,
                          const float* scale_base) {
  const int lane = threadIdx.x & 63, gw = bid * 4 + (threadIdx.x >> 6), nw = nblk * 4;
  const u16* ybuf = (const u16*)(p.ws + OFF_YBUF);
  const float* ssq = (const float*)(p.ws + OFF_SSQ);
  u16* hout = (u16*)(p.ws + OFF_HA);
  for (int row = gw; row < NTOK; row += nw) {
    const int b = row / SEQ;
    float v[16];
    load_row16(xin + (size_t)row * D, lane, v);
    float sy = (lane < 16) ? ssq[(size_t)row * 16 + lane] : 0.f;
    sy = wave_sum(sy);
    const float rstd_y = rsqrtf(sy * (1.f / D) + 1e-6f);
    const float* gate = gate_base + (size_t)b * 6144;
    float ss = 0.f;
#pragma unroll
    for (int s = 0; s < 4; ++s) {
      const int c = lane * 4 + 256 * s;
      const uint2 yy = *(const uint2*)(ybuf + (size_t)row * D + c);
      const float4 gt = *(const float4*)(gate + c), gp = *(const float4*)(gpost + c);
      v[s * 4 + 0] += gt.x * (lo2f(yy.x) * rstd_y * gp.x);
      v[s * 4 + 1] += gt.y * (hi2f(yy.x) * rstd_y * gp.y);
      v[s * 4 + 2] += gt.z * (lo2f(yy.y) * rstd_y * gp.z);
      v[s * 4 + 3] += gt.w * (hi2f(yy.y) * rstd_y * gp.w);
      *(float4*)(xout + (size_t)row * D + c) = make_float4(v[s * 4], v[s * 4 + 1], v[s * 4 + 2], v[s * 4 + 3]);
#pragma unroll
      for (int e = 0; e < 4; ++e) ss += v[s * 4 + e] * v[s * 4 + e];
    }
    if (has_next) {
      ss = wave_sum(ss);
      const float rstd = rsqrtf(ss * (1.f / D) + 1e-6f);
      norm_mod_store(v, rstd, gnext, shift_base + (size_t)b * 6144, scale_base + (size_t)b * 6144, hout + (size_t)row * D, lane);
    }
  }
}

struct EpiInproj {
  const Params* p; int c0; int t0; bool isctx;
  DEV f32x4 store(int i, int j, f32x4 v) {
    const int c = c0 + i, t = t0 + j;
    char* ws = p->ws;
    uint2 o; o.x = pack2(v[0], v[1]); o.y = pack2(v[2], v[3]);
    if (!isctx) {
      if (c < 512) *(uint2*)((u16*)(ws + OFF_QB) + (size_t)t * 512 + c) = o;
      else if (c < 1536) *(uint2*)((u16*)(ws + OFF_ZB) + (size_t)t * 1024 + (c - 512)) = o;
      else if (c < 2048) *(uint2*)((u16*)(ws + OFF_KB) + (size_t)t * 512 + (c - 1536)) = o;
      else if (c < 2560) *(uint2*)((u16*)(ws + OFF_VB) + (size_t)t * 512 + (c - 2048)) = o;
      else if (c < 4608) {
        *(uint2*)((u16*)(ws + OFF_XBC) + (size_t)t * XBCW + (c - 2560)) = o;
        const int seg = t >> 6, w = t & 63;
        u16* halo = (u16*)(ws + OFF_HALO);
        if (w == 63 && seg + 1 < 512) *(uint2*)(halo + ((size_t)(seg + 1) * 2 + 0) * XBCW + (c - 2560)) = o;
        if (w == 0 && seg > 0) *(uint2*)(halo + ((size_t)(seg - 1) * 2 + 1) * XBCW + (c - 2560)) = o;
      } else if (c < INW) *(float4*)((float*)(ws + OFF_DTRAW) + (size_t)t * 32 + (c - 4608)) = make_float4(v[0], v[1], v[2], v[3]);
    } else {
      if (c < 2048) *(uint2*)((u16*)(ws + OFF_KC) + (size_t)t * 512 + (c - 1536)) = o;
      else if (c < 2560) *(uint2*)((u16*)(ws + OFF_VC) + (size_t)t * 512 + (c - 2048)) = o;
      else if (c < 4608) {
        *(uint2*)((u16*)(ws + OFF_XBCC) + (size_t)t * XBCW + (c - 2560)) = o;
        const int seg = t >> 6, w = t & 63;
        u16* halo = (u16*)(ws + OFF_HALO) + (size_t)512 * 2 * XBCW;
        if (w == 63 && seg + 1 < 32) *(uint2*)(halo + ((size_t)(seg + 1) * 2 + 0) * XBCW + (c - 2560)) = o;
        if (w == 0 && seg > 0) *(uint2*)(halo + ((size_t)(seg - 1) * 2 + 1) * XBCW + (c - 2560)) = o;
      } else if (c < INW) *(float4*)((float*)(ws + OFF_DTRAWC) + (size_t)t * 32 + (c - 4608)) = make_float4(v[0], v[1], v[2], v[3]);
    }
    return v;
  }
  DEV void ssq(int, int, float) {}
};

DEV void phase_inproj(const Params& p, char* smem, int bid, int nblk) {
  constexpr int NI = 37, NJ = NTOK / 128, NIC = 25, NJC = NCTX / 128;
  const int total = NI * NJ + NIC * NJC;
  const u16* WinT = (const u16*)(p.ws + OFF_WIN);
  for (int id = bid; id < total; id += nblk) {
    if (id < NI * NJ) {
      const int it = id % NI, jt = id / NI;
      SrcPlain ps{WinT + (size_t)it * 128 * 1024, 1024};
      SrcPlain qs{(const u16*)(p.ws + OFF_HA) + (size_t)jt * 128 * 1024, 1024};
      EpiInproj epi{&p, it * 128, jt * 128, false};
      gemm_tile<false>(ps, qs, 1024, smem, epi);
    } else {
      const int id2 = id - NI * NJ;
      const int it = id2 % NIC, jt = id2 / NIC;
      SrcPlain ps{WinT + (size_t)(1536 + it * 128) * 1024, 1024};
      SrcPlain qs{(const u16*)(p.ws + OFF_HC) + (size_t)jt * 128 * 1024, 1024};
      EpiInproj epi{&p, 1536 + it * 128, jt * 128, true};
      gemm_tile<false>(ps, qs, 1024, smem, epi);
    }
  }
}

DEV void phase_conv(const Params& p, int bid, int nblk) {
  const int tid = threadIdx.x;
  const int c8 = tid * 8;
  float w0[8], w1[8], w2[8], bb[8];
#pragma unroll
  for (int e = 0; e < 8; ++e) {
    w0[e] = p.conv_w[c8 + e]; w1[e] = p.conv_w[XBCW + c8 + e]; w2[e] = p.conv_w[2 * XBCW + c8 + e]; bb[e] = p.conv_b[c8 + e];
  }
  for (int seg = bid; seg < 512 + 32; seg += nblk) {
    const bool isctx = seg >= 512;
    const int sl = isctx ? seg - 512 : seg;
    u16* base = (isctx ? (u16*)(p.ws + OFF_XBCC) : (u16*)(p.ws + OFF_XBC)) + (size_t)sl * 64 * XBCW + c8;
    const u16* halo = (const u16*)(p.ws + OFF_HALO) + (size_t)seg * 2 * XBCW + c8;
    const int L = isctx ? CTXL : SEQ;
    const int tin0 = (sl * 64) % L;
    float prev[8], cur[8], nxt[8];
    if (tin0 == 0) {
#pragma unroll
      for (int e = 0; e < 8; ++e) prev[e] = 0.f;
    } else unpack8(*(const uint4*)(halo), prev);
    unpack8(*(const uint4*)(base), cur);
    for (int r = 0; r < 64; ++r) {
      if (r < 63) unpack8(*(const uint4*)(base + (size_t)(r + 1) * XBCW), nxt);
      else if (tin0 + 64 == L) {
#pragma unroll
        for (int e = 0; e < 8; ++e) nxt[e] = 0.f;
      } else unpack8(*(const uint4*)(halo + XBCW), nxt);
      float o[8];
#pragma unroll
      for (int e = 0; e < 8; ++e) o[e] = silu_f(w0[e] * prev[e] + w1[e] * cur[e] + w2[e] * nxt[e] + bb[e]);
      *(uint4*)(base + (size_t)r * XBCW) = pack8(o);
#pragma unroll
      for (int e = 0; e < 8; ++e) { prev[e] = cur[e]; cur[e] = nxt[e]; }
    }
  }
}

DEV void ssd_naive_item(const Params& p, int item, char* smem) {
  const int tid = threadIdx.x;
  const int dir = item & 1, h = (item >> 1) & 15, b = item >> 5;
  const int g = h >> 2;
  const int pp = tid >> 2, nq = tid & 3;
  const float A = __expf(p.a_log[dir * 16 + h]);
  const float dtb = p.dt_bias[dir * 16 + h];
  float st[32];
#pragma unroll
  for (int e = 0; e < 32; ++e) st[e] = 0.f;
  u16* sx = (u16*)smem;
  float* sdt = (float*)(smem + 32 * 640);
  u16* Yd = (u16*)(p.ws + (dir ? OFF_Y1 : OFF_Y0));
  for (int part = 0; part < 2; ++part) {
    const int L = part == 0 ? CTXL : SEQ;
    const u16* xb = part == 0 ? (const u16*)(p.ws + OFF_XBCC) + (size_t)b * CTXL * XBCW
                              : (const u16*)(p.ws + OFF_XBC) + (size_t)b * SEQ * XBCW;
    const float* dtr = part == 0 ? (const float*)(p.ws + OFF_DTRAWC) + (size_t)b * CTXL * 32
                                 : (const float*)(p.ws + OFF_DTRAW) + (size_t)b * SEQ * 32;
    for (int s0 = 0; s0 < L; s0 += 32) {
      __syncthreads();
      for (int e = tid; e < 32 * 40; e += 256) {
        const int s = e / 40, ch = e % 40;
        const int t = dir ? (L - 1 - (s0 + s)) : (s0 + s);
        const u16* row = xb + (size_t)t * XBCW;
        const u16* src = ch < 8 ? row + h * 64 + ch * 8 : (ch < 24 ? row + 1024 + g * 128 + (ch - 8) * 8 : row + 1536 + g * 128 + (ch - 24) * 8);
        *(uint4*)(sx + s * 320 + ch * 8) = *(const uint4*)src;
      }
      if (tid < 32) {
        const int t = dir ? (L - 1 - (s0 + tid)) : (s0 + tid);
        const float dt = softplus_f(dtr[(size_t)t * 32 + dir * 16 + h] + dtb);
        sdt[tid] = dt;
        sdt[32 + tid] = __expf(-dt * A);
      }
      __syncthreads();
      for (int s = 0; s < 32; ++s) {
        const float dt = sdt[s], dec = sdt[32 + s];
        const float xdt = bf2f(sx[s * 320 + pp]) * dt;
        float y = 0.f;
        const u16* Bp = sx + s * 320 + 64 + nq * 32;
        const u16* Cp = sx + s * 320 + 192 + nq * 32;
#pragma unroll
        for (int q = 0; q < 4; ++q) {
          float bv[8], cv[8];
          unpack8(*(const uint4*)(Bp + q * 8), bv);
          unpack8(*(const uint4*)(Cp + q * 8), cv);
#pragma unroll
          for (int e = 0; e < 8; ++e) {
            st[q * 8 + e] = st[q * 8 + e] * dec + bv[e] * xdt;
            y += cv[e] * st[q * 8 + e];
          }
        }
        if (part == 1) {
          y += __shfl_xor(y, 1);
          y += __shfl_xor(y, 2);
          if (nq == 0) {
            const int t = dir ? (L - 1 - (s0 + s)) : (s0 + s);
            Yd[((size_t)b * SEQ + t) * 1024 + h * 64 + pp] = f2bf(y);
          }
        }
      }
    }
  }
}

DEV void attn_naive(const Params& p, int gw, int nw) {
  const int lane = threadIdx.x & 63;
  u16* Qb = (u16*)(p.ws + OFF_QB);
  const u16* Kb = (const u16*)(p.ws + OFF_KB);
  const u16* Vb = (const u16*)(p.ws + OFF_VB);
  const u16* Kc = (const u16*)(p.ws + OFF_KC);
  const u16* Vc = (const u16*)(p.ws + OFF_VC);
  for (int pair = gw; pair < NTOK * 8; pair += nw) {
    const int token = pair >> 3, h = pair & 7;
    const int b = token / SEQ, t = token % SEQ, r = t >> 6, qc = t & 63;
    const int rs = min(max(r - 4, 0), 56), cs = min(max(qc - 8, 0), 48);
    const float qv = bf2f(Qb[(size_t)token * 512 + h * 64 + lane]);
    float sc[6];
    const u16* kptr[6];
#pragma unroll
    for (int s = 0; s < 6; ++s) {
      const int kk = lane + 64 * s;
      if (s < 2) {
        const int wr = kk >> 4, wc = kk & 15;
        const int kt = b * SEQ + (rs + wr) * 64 + cs + wc;
        kptr[s] = Kb + (size_t)kt * 512 + h * 64;
        sc[s] = p.na_rpb[(h * 15 + (rs + wr - r + 7)) * 31 + (cs + wc - qc + 15)];
      } else {
        kptr[s] = Kc + (size_t)(b * CTXL + kk - 128) * 512 + h * 64;
        sc[s] = 0.f;
      }
    }
    float dot[6] = {0.f, 0.f, 0.f, 0.f, 0.f, 0.f};
#pragma unroll
    for (int d8 = 0; d8 < 8; ++d8) {
      float qd[8];
#pragma unroll
      for (int e = 0; e < 8; ++e) qd[e] = __shfl(qv, d8 * 8 + e);
#pragma unroll
      for (int s = 0; s < 6; ++s) {
        float kv[8];
        unpack8(*(const uint4*)(kptr[s] + d8 * 8), kv);
#pragma unroll
        for (int e = 0; e < 8; ++e) dot[s] += qd[e] * kv[e];
      }
    }
    float m = -1e30f;
#pragma unroll
    for (int s = 0; s < 6; ++s) { sc[s] += dot[s] * 0.125f; m = fmaxf(m, sc[s]); }
    m = wave_max(m);
    float sum = 0.f;
#pragma unroll
    for (int s = 0; s < 6; ++s) { sc[s] = __expf(sc[s] - m); sum += sc[s]; }
    sum = wave_sum(sum);
    float o = 0.f;
#pragma unroll
    for (int s = 0; s < 6; ++s) {
      for (int src = 0; src < 64; ++src) {
        const float pv = __shfl(sc[s], src);
        const int kk = src + 64 * s;
        const u16* vp;
        if (s < 2) {
          const int wr = kk >> 4, wc = kk & 15;
          vp = Vb + (size_t)(b * SEQ + (rs + wr) * 64 + cs + wc) * 512 + h * 64;
        } else vp = Vc + (size_t)(b * CTXL + kk - 128) * 512 + h * 64;
        o += pv * bf2f(vp[lane]);
      }
    }
    Qb[(size_t)token * 512 + h * 64 + lane] = f2bf(o / sum);
  }
}

DEV void phase_mixer(const Params& p, char* smem, int bid, int nblk) {
  if (nblk >= 512) {
    if (bid < 256) ssd_naive_item(p, bid, smem);
    else attn_naive(p, (bid - 256) * 4 + (threadIdx.x >> 6), (nblk - 256) * 4);
  } else {
    for (int it = bid; it < 256; it += nblk) ssd_naive_item(p, it, smem);
    attn_naive(p, bid * 4 + (threadIdx.x >> 6), nblk * 4);
  }
}

DEV void phase_gated(const Params& p, char* smem, int bid, int nblk) {
  constexpr int NUP = 16 * 88, NDN = 44 * 16;
  for (int id = bid; id < 2 * (NUP + NDN); id += nblk) {
    const int l = id / (NUP + NDN), r = id % (NUP + NDN);
    if (r < NUP) convert_tile(p.w_up + (size_t)l * D * FFH2, D, FFH2, (u16*)(p.ws + OFF_WUP + l * WUP_SZ), r / 88, r % 88, smem);
    else convert_tile(p.w_down + (size_t)l * FFH * D, FFH, D, (u16*)(p.ws + OFF_WDOWN + l * WDOWN_SZ), (r - NUP) / 16, (r - NUP) % 16, smem);
  }
  const int lane = threadIdx.x & 63, gw = bid * 4 + (threadIdx.x >> 6), nw = nblk * 4;
  u16* Y0 = (u16*)(p.ws + OFF_Y0);
  const u16* Y1 = (const u16*)(p.ws + OFF_Y1);
  const u16* Zb = (const u16*)(p.ws + OFF_ZB);
  const u16* Xs = (const u16*)(p.ws + OFF_XBC);
  for (int row = gw; row < NTOK; row += nw) {
    float yz[16];
    float gs[4];
#pragma unroll
    for (int s = 0; s < 4; ++s) {
      const int c = lane * 4 + 256 * s;
      const int hh = c >> 6;
      const float dsk = p.ssm_d[hh] + p.ssm_d[16 + hh];
      const uint2 a = *(const uint2*)(Y0 + (size_t)row * D + c);
      const uint2 bq = *(const uint2*)(Y1 + (size_t)row * D + c);
      const uint2 z = *(const uint2*)(Zb + (size_t)row * D + c);
      const uint2 xs = *(const uint2*)(Xs + (size_t)row * XBCW + c);
      const float y0 = lo2f(a.x) + lo2f(bq.x) + dsk * lo2f(xs.x);
      const float y1 = hi2f(a.x) + hi2f(bq.x) + dsk * hi2f(xs.x);
      const float y2 = lo2f(a.y) + lo2f(bq.y) + dsk * lo2f(xs.y);
      const float y3 = hi2f(a.y) + hi2f(bq.y) + dsk * hi2f(xs.y);
      yz[s * 4 + 0] = y0 * silu_f(lo2f(z.x));
      yz[s * 4 + 1] = y1 * silu_f(hi2f(z.x));
      yz[s * 4 + 2] = y2 * silu_f(lo2f(z.y));
      yz[s * 4 + 3] = y3 * silu_f(hi2f(z.y));
      float q = 0.f;
#pragma unroll
      for (int e = 0; e < 4; ++e) q += yz[s * 4 + e] * yz[s * 4 + e];
      gs[s] = wave_sum(q);
    }
#pragma unroll
    for (int s = 0; s < 4; ++s) {
      const int c = lane * 4 + 256 * s;
      const float rstd = rsqrtf(gs[s] * (1.f / 256.f) + 1e-6f);
      const float4 g = *(const float4*)(p.ssm_norm_g + c);
      uint2 o;
      o.x = pack2(yz[s * 4 + 0] * rstd * g.x, yz[s * 4 + 1] * rstd * g.y);
      o.y = pack2(yz[s * 4 + 2] * rstd * g.z, yz[s * 4 + 3] * rstd * g.w);
      *(uint2*)(Y0 + (size_t)row * D + c) = o;
    }
  }
}

struct EpiY {
  u16* ybuf; float* ssqb; int c0; int t0; int it; const float* bias; const float* scale;
  DEV f32x4 store(int i, int j, f32x4 v) {
    const int c = c0 + i, t = t0 + j;
    if (bias) {
      const float4 bb = *(const float4*)(bias + c), sc = *(const float4*)(scale + c);
      v[0] = (v[0] + bb.x) * sc.x; v[1] = (v[1] + bb.y) * sc.y; v[2] = (v[2] + bb.z) * sc.z; v[3] = (v[3] + bb.w) * sc.w;
    }
    uint2 o; o.x = pack2(v[0], v[1]); o.y = pack2(v[2], v[3]);
    *(uint2*)(ybuf + (size_t)t * D + c) = o;
    return v;
  }
  DEV void ssq(int j, int wi, float s) { ssqb[(size_t)(t0 + j) * 16 + it * 2 + wi] = s; }
};

DEV void phase_outproj(const Params& p, char* smem, int bid, int nblk) {
  constexpr int NI = 8, NJ = NTOK / 128;
  const u16* WT = (const u16*)(p.ws + OFF_WOUT);
  for (int id = bid; id < NI * NJ; id += nblk) {
    const int it = id % NI, jt = id / NI;
    SrcPlain ps{WT + (size_t)it * 128 * MIXW, MIXW};
    SrcCat qs{(const u16*)(p.ws + OFF_QB) + (size_t)jt * 128 * 512, 512, 512, (const u16*)(p.ws + OFF_Y0) + (size_t)jt * 128 * D, D};
    EpiY epi{(u16*)(p.ws + OFF_YBUF), (float*)(p.ws + OFF_SSQ), it * 128, jt * 128, it, nullptr, nullptr};
    gemm_tile<true>(ps, qs, MIXW, smem, epi);
  }
}

DEV void phase_poolgemm(const Params& p, char* smem, int bid, int nblk) {
  constexpr int NI = 8, NJ = NTOK / 128;
  const u16* WT = (const u16*)(p.ws + OFF_POOLT);
  for (int id = bid; id < NI * NJ; id += nblk) {
    const int it = id % NI, jt = id / NI, g = it >> 1;
    SrcPlain ps{WT + (size_t)g * 65536 + (size_t)(it & 1) * 128 * 256, 256};
    SrcPlain qs{(const u16*)(p.ws + OFF_POOLED) + (size_t)jt * 128 * D + g * 256, D};
    EpiY epi{(u16*)(p.ws + OFF_YBUF), (float*)(p.ws + OFF_SSQ), it * 128, jt * 128, it, p.pool_b, p.pool_scale};
    gemm_tile<true>(ps, qs, 256, smem, epi);
  }
}

struct EpiUV {
  u16* uv; int c0; int t0;
  DEV f32x4 store(int i, int j, f32x4 v) {
    uint2 o; o.x = pack2(v[0], v[1]); o.y = pack2(v[2], v[3]);
    *(uint2*)(uv + (size_t)(t0 + j) * FFH2 + c0 + i) = o;
    return v;
  }
  DEV void ssq(int, int, float) {}
};

constexpr int HALF_TOK = NTOK / 2;
DEV void phase_up(const Params& p, char* smem, int bid, int nblk, int l, int half) {
  constexpr int NI = FFH2 / 128, NJ = HALF_TOK / 128;
  const u16* WT = (const u16*)(p.ws + OFF_WUP + l * WUP_SZ);
  for (int id = bid; id < NI * NJ; id += nblk) {
    const int it = id % NI, jt = id / NI;
    SrcPlain ps{WT + (size_t)it * 128 * D, D};
    SrcPlain qs{(const u16*)(p.ws + OFF_HA) + (size_t)(half * HALF_TOK + jt * 128) * D, D};
    EpiUV epi{(u16*)(p.ws + OFF_UV), it * 128, jt * 128};
    gemm_tile<false>(ps, qs, D, smem, epi);
  }
}

DEV void phase_gate(const Params& p, int bid, int nblk, int l) {
  const u16* uv = (const u16*)(p.ws + OFF_UV);
  u16* gact = (u16*)(p.ws + OFF_GACT);
  const float* cw = p.fconv_w + (size_t)l * 3 * FFH;
  const float* cb = p.fconv_b + (size_t)l * FFH;
  const int ntask = (HALF_TOK / 32) * 352;
  for (int task = bid * 256 + threadIdx.x; task < ntask; task += nblk * 256) {
    const int tb = task / 352, cc = task % 352, c8 = cc * 8;
    float w0[8], w1[8], w2[8], bb[8];
#pragma unroll
    for (int e = 0; e < 8; ++e) { w0[e] = cw[c8 + e]; w1[e] = cw[FFH + c8 + e]; w2[e] = cw[2 * FFH + c8 + e]; bb[e] = cb[c8 + e]; }
    const int t0 = tb * 32;
    float prev[8], cur[8], nxt[8];
    if ((t0 % SEQ) == 0) {
#pragma unroll
      for (int e = 0; e < 8; ++e) prev[e] = 0.f;
    } else unpack8(*(const uint4*)(uv + (size_t)(t0 - 1) * FFH2 + c8), prev);
    unpack8(*(const uint4*)(uv + (size_t)t0 * FFH2 + c8), cur);
    for (int r = 0; r < 32; ++r) {
      const int t = t0 + r;
      if ((t % SEQ) == SEQ - 1) {
#pragma unroll
        for (int e = 0; e < 8; ++e) nxt[e] = 0.f;
      } else unpack8(*(const uint4*)(uv + (size_t)(t + 1) * FFH2 + c8), nxt);
      float vv[8], o[8];
      unpack8(*(const uint4*)(uv + (size_t)t * FFH2 + FFH + c8), vv);
#pragma unroll
      for (int e = 0; e < 8; ++e) {
        const float u = w0[e] * prev[e] + w1[e] * cur[e] + w2[e] * nxt[e] + bb[e];
        o[e] = 0.5f * u * (1.f + erff(u * 0.70710678118f)) * vv[e];
      }
      *(uint4*)(gact + (size_t)t * FFH + c8) = pack8(o);
#pragma unroll
      for (int e = 0; e < 8; ++e) { prev[e] = cur[e]; cur[e] = nxt[e]; }
    }
  }
}

DEV void phase_down(const Params& p, char* smem, int bid, int nblk, int l, int half) {
  constexpr int NI = 8, NJ = HALF_TOK / 128;
  const u16* WT = (const u16*)(p.ws + OFF_WDOWN + l * WDOWN_SZ);
  for (int id = bid; id < NI * NJ; id += nblk) {
    const int it = id % NI, jt = id / NI;
    SrcPlain ps{WT + (size_t)it * 128 * FFH, FFH};
    SrcPlain qs{(const u16*)(p.ws + OFF_GACT) + (size_t)jt * 128 * FFH, FFH};
    EpiY epi{(u16*)(p.ws + OFF_YBUF), (float*)(p.ws + OFF_SSQ), it * 128, half * HALF_TOK + jt * 128, it, nullptr, nullptr};
    gemm_tile<true>(ps, qs, FFH, smem, epi);
  }
}

DEV void phase_pool(const Params& p, int bid, int nblk) {
  const u16* h1 = (const u16*)(p.ws + OFF_HA);
  u16* pooled = (u16*)(p.ws + OFF_POOLED);
  const int ntask = NTOK * 128;
  for (int task = bid * 256 + threadIdx.x; task < ntask; task += nblk * 256) {
    const int token = task >> 7, cc = task & 127, c8 = cc * 8;
    const int gi = cc >> 5, w = 2 << gi;
    const int b = token / SEQ, t = token % SEQ;
    const int lo = max(t - w / 2, 0), hi = min(t - w / 2 + w, SEQ);
    float s[8], self[8];
#pragma unroll
    for (int e = 0; e < 8; ++e) s[e] = 0.f;
    for (int tt = lo; tt < hi; ++tt) {
      float v[8];
      unpack8(*(const uint4*)(h1 + ((size_t)b * SEQ + tt) * D + c8), v);
#pragma unroll
      for (int e = 0; e < 8; ++e) s[e] += v[e];
    }
    unpack8(*(const uint4*)(h1 + (size_t)token * D + c8), self);
    const float inv = 1.f / (float)(hi - lo);
    float o[8];
#pragma unroll
    for (int e = 0; e < 8; ++e) o[e] = s[e] * inv - self[e];
    *(uint4*)(pooled + (size_t)token * D + c8) = pack8(o);
  }
}

constexpr int N_PHASES = 25;
DEV void run_phase(const Params& p, int ph, char* smem, int bid, int nblk) {
  const float* mod = (const float*)(p.ws + OFF_MOD);
  const float* mod1 = mod + 9 * 6144;
  switch (ph) {
    case 0: phase0(p, smem, bid, nblk); break;
    case 1: phase_norm_in(p, bid, nblk); break;
    case 2: phase_inproj(p, smem, bid, nblk); break;
    case 3: phase_conv(p, bid, nblk); break;
    case 4: phase_mixer(p, smem, bid, nblk); break;
    case 5: phase_gated(p, smem, bid, nblk); break;
    case 6: phase_outproj(p, smem, bid, nblk); break;
    case 7: phase_row_update(p, bid, nblk, p.x, p.out, mod + 2048, p.norm_g + 1024, true, p.norm_g + 2048, mod + 3072, mod + 4096); break;
    case 8: phase_up(p, smem, bid, nblk, 0, 0); break;
    case 9: phase_gate(p, bid, nblk, 0); break;
    case 10: phase_down(p, smem, bid, nblk, 0, 0); break;
    case 11: phase_up(p, smem, bid, nblk, 0, 1); break;
    case 12: phase_gate(p, bid, nblk, 0); break;
    case 13: phase_down(p, smem, bid, nblk, 0, 1); break;
    case 14: phase_row_update(p, bid, nblk, p.out, p.out, mod + 5120, p.norm_g + 3072, true, p.norm_g + 4096, mod1, mod1 + 1024); break;
    case 15: phase_pool(p, bid, nblk); break;
    case 16: phase_poolgemm(p, smem, bid, nblk); break;
    case 17: phase_row_update(p, bid, nblk, p.out, p.out, mod1 + 2048, p.norm_g + 4096 + 1024, true, p.norm_g + 4096 + 2048, mod1 + 3072, mod1 + 4096); break;
    case 18: phase_up(p, smem, bid, nblk, 1, 0); break;
    case 19: phase_gate(p, bid, nblk, 1); break;
    case 20: phase_down(p, smem, bid, nblk, 1, 0); break;
    case 21: phase_up(p, smem, bid, nblk, 1, 1); break;
    case 22: phase_gate(p, bid, nblk, 1); break;
    case 23: phase_down(p, smem, bid, nblk, 1, 1); break;
    case 24: phase_row_update(p, bid, nblk, p.out, p.out, mod1 + 5120, p.norm_g + 4096 + 3072, false, nullptr, nullptr, nullptr); break;
    default: break;
  }
}

__global__ void __launch_bounds__(256, 2) phase_kernel(Params p, int ph) {
  __shared__ __attribute__((aligned(16))) char smem[65536];
  run_phase(p, ph, smem, blockIdx.x, gridDim.x);
}

#if MK_COOP
__global__ void __launch_bounds__(256, 2) mega_kernel(Params p) {
  __shared__ __attribute__((aligned(16))) char smem[65536];
  cg::grid_group grid = cg::this_grid();
  for (int ph = 0; ph < N_PHASES; ++ph) {
    run_phase(p, ph, smem, blockIdx.x, gridDim.x);
    if (ph + 1 < N_PHASES) grid.sync();
  }
}
#endif

extern "C" void kernel_launch(void* const* d_in, const int* in_sizes, int n_in, void* d_out, int out_size, void* d_ws,
                              size_t ws_size, hipStream_t stream) {
  Params p{};
  const float** f = (const float**)&p;
  for (int i = 0; i < 23; ++i) f[i] = (const float*)d_in[i];
  p.out = (float*)d_out;
  p.ws = (char*)d_ws;
#if MK_COOP
  static int grid_blocks = 0;
  if (!grid_blocks) {
    int dev = 0, cus = 0, per_cu = 0;
    hipGetDevice(&dev);
    hipDeviceGetAttribute(&cus, hipDeviceAttributeMultiprocessorCount, dev);
    hipOccupancyMaxActiveBlocksPerMultiprocessor(&per_cu, mega_kernel, 256, 0);
    if (per_cu > 2) per_cu = 2;
    grid_blocks = cus * per_cu;
  }
  void* args[] = {&p};
  hipError_t e = hipLaunchCooperativeKernel((void*)mega_kernel, dim3(grid_blocks), dim3(256), args, 0, stream);
  if (e != hipSuccess) fprintf(stderr, "cooperative launch failed: %s (grid %d)\n", hipGetErrorString(e), grid_blocks);
#else
  for (int ph = 0; ph < N_PHASES; ++ph) phase_kernel<<<512, 256, 0, stream>>>(p, ph);
#endif
}
```

```cpp
#include <hip/hip_runtime.h>
#include <hip/hip_cooperative_groups.h>
#include <cstdio>
namespace cg = cooperative_groups;

#ifndef MK_COOP
#define MK_COOP 1
#endif

#define DEV __device__ __forceinline__
#define PHASE_FN __device__ __forceinline__
typedef unsigned short u16;
typedef __attribute__((ext_vector_type(8))) short bf16x8;
typedef __attribute__((ext_vector_type(4))) float f32x4;

constexpr int D = 1024, NB = 8, SEQ = 4096, NTOK = NB * SEQ, CTXL = 256, NCTX = NB * CTXL;
constexpr int INW = 4640, INWP = 4864, MIXW = 1536, FFH = 2816, FFH2 = 5632;
constexpr int XBCW = 2048;
constexpr size_t MiB = 1u << 20;
constexpr size_t OFF_WIN = 0, OFF_WOUT = 10 * MiB, OFF_POOLT = 13 * MiB, OFF_MOD = 14 * MiB,
                 OFF_DTRAW = 15 * MiB, OFF_DTRAWC = 19 * MiB, OFF_SSQ = 20 * MiB, OFF_CNT = 22 * MiB,
                 OFF_KC = 24 * MiB, OFF_VC = 26 * MiB, OFF_XBCC = 28 * MiB, OFF_HA = 36 * MiB,
                 OFF_Y1 = OFF_HA, OFF_HC = 100 * MiB, OFF_QB = 104 * MiB, OFF_Y0 = 136 * MiB,
                 OFF_ZB = 200 * MiB, OFF_YBUF = 264 * MiB, OFF_KB = 264 * MiB, OFF_VB = 296 * MiB, OFF_RES = 100 * MiB,
                 OFF_WUP = 228 * MiB, OFF_WDOWN = 250 * MiB, OFF_XBC = 328 * MiB, OFF_VT = 456 * MiB,
                 OFF_HALO = 488 * MiB, OFF_VCT = 494 * MiB, OFF_UV = 328 * MiB, OFF_GACT = 104 * MiB, OFF_POOLED = 328 * MiB;
constexpr size_t WUP_SZ = (size_t)FFH2 * D * 2, WDOWN_SZ = (size_t)D * FFH * 2;

struct Params {
  const float *x, *c, *ctx, *c_ctx, *ada_w, *ada_b, *norm_g, *w_in, *w_out, *na_rpb, *conv_w, *conv_b,
      *a_log, *dt_bias, *ssm_d, *ssm_norm_g, *pool_w, *pool_b, *pool_scale, *w_up, *fconv_w, *fconv_b, *w_down;
  float* out;
  char* ws;
};

DEV int ltid() { int t = (int)__builtin_amdgcn_workitem_id_x(); asm volatile("" : "+v"(t)); return t; }
DEV int vtid() { return ltid() & 255; }
DEV int vhalf() { return ltid() >> 8; }
constexpr int SMEM_BYTES = 143360;
DEV void lds_barrier() {
  asm volatile("s_waitcnt lgkmcnt(0)" ::: "memory");
  __builtin_amdgcn_s_barrier();
  asm volatile("" ::: "memory");
}
typedef unsigned u32x4v __attribute__((ext_vector_type(4)));
DEV void nt_store16(void* p, uint4 v) {
  const u32x4v t = {v.x, v.y, v.z, v.w};
  __builtin_nontemporal_store(t, (u32x4v*)p);
}
DEV u16 f2bf(float f) {
  unsigned u = __float_as_uint(f);
  u += 0x7fffu + ((u >> 16) & 1u);
  return (u16)(u >> 16);
}
DEV float bf2f(u16 h) { return __uint_as_float(((unsigned)h) << 16); }
typedef __attribute__((ext_vector_type(2))) __bf16 bf16x2_t;
typedef __attribute__((ext_vector_type(2))) float f32x2_t;
DEV unsigned pack2(float a, float b) {
  f32x2_t v = {a, b};
  return __builtin_bit_cast(unsigned, __builtin_convertvector(v, bf16x2_t));
}
typedef __attribute__((ext_vector_type(4))) short s16x4;
DEV s16x4 lds_tr(const char* p) { return __builtin_amdgcn_ds_read_tr16_b64_v4i16((__attribute__((address_space(3))) s16x4*)p); }
DEV bf16x8 cat4(s16x4 a, s16x4 b) { return bf16x8{a[0], a[1], a[2], a[3], b[0], b[1], b[2], b[3]}; }
DEV float lo2f(unsigned u) { return __uint_as_float(u << 16); }
DEV float hi2f(unsigned u) { return __uint_as_float(u & 0xffff0000u); }
typedef unsigned u32x2s __attribute__((ext_vector_type(2)));
DEV float max_x16(float x) { const u32x2s r = __builtin_amdgcn_permlane16_swap(__float_as_uint(x), __float_as_uint(x), false, false); return fmaxf(__uint_as_float(r[0]), __uint_as_float(r[1])); }
DEV float max_x32(float x) { const u32x2s r = __builtin_amdgcn_permlane32_swap(__float_as_uint(x), __float_as_uint(x), false, false); return fmaxf(__uint_as_float(r[0]), __uint_as_float(r[1])); }
DEV float sum_x16(float x) { const u32x2s r = __builtin_amdgcn_permlane16_swap(__float_as_uint(x), __float_as_uint(x), false, false); return __uint_as_float(r[0]) + __uint_as_float(r[1]); }
DEV float sum_x32(float x) { const u32x2s r = __builtin_amdgcn_permlane32_swap(__float_as_uint(x), __float_as_uint(x), false, false); return __uint_as_float(r[0]) + __uint_as_float(r[1]); }
DEV float wave_sum(float v) {
  v = sum_x32(v);
  v = sum_x16(v);
#pragma unroll
  for (int o = 8; o > 0; o >>= 1) v += __shfl_xor(v, o);
  return v;
}
DEV float wave_max(float v) {
  v = max_x32(v);
  v = max_x16(v);
#pragma unroll
  for (int o = 8; o > 0; o >>= 1) v = fmaxf(v, __shfl_xor(v, o));
  return v;
}
DEV float silu_f(float v) { return v * __builtin_amdgcn_rcpf(1.f + __expf(-v)); }
DEV float erf_f(float x) {
  const float ax = fabsf(x);
  const float t = __builtin_amdgcn_rcpf(1.f + 0.3275911f * ax);
  float poly = 1.061405429f;
  poly = poly * t - 1.453152027f;
  poly = poly * t + 1.421413741f;
  poly = poly * t - 0.284496736f;
  poly = poly * t + 0.254829592f;
  poly *= t;
  const float r = 1.f - poly * __builtin_amdgcn_exp2f(-1.44269504089f * ax * ax);
  return copysignf(r, x);
}
typedef float f32x2v __attribute__((ext_vector_type(2)));
DEV f32x2v gelu2(f32x2v u) {
  const f32x2v z = u * 0.70710678118f;
  const f32x2v az = {fabsf(z.x), fabsf(z.y)};
  const f32x2v den = az * 0.3275911f + 1.f;
  const f32x2v t = {__builtin_amdgcn_rcpf(den.x), __builtin_amdgcn_rcpf(den.y)};
  f32x2v poly = t * 1.061405429f - 1.453152027f;
  poly = poly * t + 1.421413741f;
  poly = poly * t - 0.284496736f;
  poly = poly * t + 0.254829592f;
  poly = poly * t;
  const f32x2v ex = az * az * (-1.44269504089f);
  const f32x2v e = {__builtin_amdgcn_exp2f(ex.x), __builtin_amdgcn_exp2f(ex.y)};
  const f32x2v r = 1.f - poly * e;
  const f32x2v er = {copysignf(r.x, z.x), copysignf(r.y, z.y)};
  return (u * 0.5f) * (er + 1.f);
}
DEV f32x2v bfpair(unsigned u) { return f32x2v{lo2f(u), hi2f(u)}; }
DEV float gelu_f(float u) { return 0.5f * u * (1.f + erf_f(u * 0.70710678118f)); }
DEV float softplus_f(float v) {
  const float e = __expf(v);
  const float small = e * (1.f - e * (0.5f - e * (1.f / 3.f)));
  return v > 20.f ? v : (e < 0.01f ? small : __logf(1.f + e));
}
DEV void unpack8(const uint4& u, float* f) {
  f[0] = lo2f(u.x); f[1] = hi2f(u.x); f[2] = lo2f(u.y); f[3] = hi2f(u.y);
  f[4] = lo2f(u.z); f[5] = hi2f(u.z); f[6] = lo2f(u.w); f[7] = hi2f(u.w);
}
DEV uint4 pack8(const float* f) {
  uint4 u;
  u.x = pack2(f[0], f[1]); u.y = pack2(f[2], f[3]); u.z = pack2(f[4], f[5]); u.w = pack2(f[6], f[7]);
  return u;
}

struct SrcPlain {
  const u16* base; int ld;
  DEV const char* kbase(int kt) const { return (const char*)(base + kt * 64); }
  DEV unsigned ldbytes(int) const { return (unsigned)ld * 2u; }
  DEV unsigned rowidx(unsigned r) const { return r; }
  DEV uint4 mask(uint4 v, unsigned) const { return v; }
};
struct SrcHalo {
  const u16* base; int ld; int t0; int tmax;
  DEV const char* kbase(int kt) const { return (const char*)(base + kt * 64); }
  DEV unsigned ldbytes(int) const { return (unsigned)ld * 2u; }
  DEV unsigned rowidx(unsigned r) const { return (unsigned)min(max(t0 + (int)r, 0), tmax); }
  DEV uint4 mask(uint4 v, unsigned r) const { return ((unsigned)(t0 + (int)r) < (unsigned)SEQ) ? v : make_uint4(0, 0, 0, 0); }
};
struct SrcCat {
  const u16* a; int lda; int ka; const u16* b; int ldb;
  DEV const char* kbase(int kt) const { return kt * 64 < ka ? (const char*)(a + kt * 64) : (const char*)(b + (kt * 64 - ka)); }
  DEV unsigned ldbytes(int kt) const { return (unsigned)(kt * 64 < ka ? lda : ldb) * 2u; }
  DEV unsigned rowidx(unsigned r) const { return r; }
  DEV uint4 mask(uint4 v, unsigned) const { return v; }
};

DEV void gemm_compute(const char* pb, int wi, int wj, int lr, int lq, f32x4 (&acc)[8][4]) {
  const char* qb = pb + 32768;
#define FR_A(dst, ks_, mh_)                                                                      \
  _Pragma("unroll") for (int m = 0; m < 4; ++m) {                                                \
    const int row = wi * 128 + ((mh_) * 4 + m) * 16 + lr;                                        \
    dst[m] = *(const bf16x8*)(pb + row * 128 + ((((ks_) * 4 + lq) ^ (row & 7)) << 4));           \
  }
#define FR_B(dst, ks_)                                                                           \
  _Pragma("unroll") for (int n = 0; n < 4; ++n) {                                                \
    const int row = wj * 64 + n * 16 + lr;                                                       \
    dst[n] = *(const bf16x8*)(qb + row * 128 + ((((ks_) * 4 + lq) ^ (row & 7)) << 4));           \
  }
#define MM(A, B, mh_)                                                                            \
  _Pragma("unroll") for (int m = 0; m < 4; ++m)                                                  \
    _Pragma("unroll") for (int n = 0; n < 4; ++n)                                                \
      acc[(mh_) * 4 + m][n] = __builtin_amdgcn_mfma_f32_16x16x32_bf16(A[m], B[n], acc[(mh_) * 4 + m][n], 0, 0, 0);
  bf16x8 b0[4], b1[4], a0[4], a1[4];
  FR_B(b0, 0) FR_A(a0, 0, 0)
  FR_A(a1, 0, 1)
  __builtin_amdgcn_sched_barrier(0);
  MM(a0, b0, 0)
  __builtin_amdgcn_sched_barrier(0);
  FR_B(b1, 1) FR_A(a0, 1, 0)
  __builtin_amdgcn_sched_barrier(0);
  MM(a1, b0, 1)
  __builtin_amdgcn_sched_barrier(0);
  FR_A(a1, 1, 1)
  __builtin_amdgcn_sched_barrier(0);
  MM(a0, b1, 0)
  __builtin_amdgcn_sched_barrier(0);
  MM(a1, b1, 1)
#undef FR_A
#undef FR_B
#undef MM
}

typedef __attribute__((address_space(3))) unsigned lds_u32_t;
template <class PS, class QS>
DEV void gemm_mainloop(const PS& ps, const QS& qs, int K, char* smem, f32x4 (&acc)[8][4]) {
  const int tid = ltid(), lane = tid & 63, wave = tid >> 6;
  const int wi = wave >> 2, wj = wave & 3, lr = lane & 15, lq = lane >> 4;
#pragma unroll
  for (int m = 0; m < 8; ++m)
#pragma unroll
    for (int n = 0; n < 4; ++n) acc[m][n] = f32x4{0.f, 0.f, 0.f, 0.f};
  const int nk = K >> 6;
  const unsigned lrow = (unsigned)(lane >> 3);
  const unsigned gch = (unsigned)(((lane & 7) ^ (lane >> 3)) << 4);
  const int wbase = __builtin_amdgcn_readfirstlane(wave * 4);
#define G_DMA(kt_, buf_)                                                                        \
  {                                                                                             \
    const char* pbse_ = ps.kbase(kt_); const unsigned pld_ = ps.ldbytes(kt_);                   \
    const char* qbse_ = qs.kbase(kt_); const unsigned qld_ = qs.ldbytes(kt_);                   \
    _Pragma("unroll") for (int s_ = 0; s_ < 4; ++s_) {                                          \
      const unsigned row_ = (unsigned)(wbase + s_) * 8u + lrow;                                 \
      __builtin_amdgcn_global_load_lds((const unsigned*)(pbse_ + (ps.rowidx(row_) * pld_ + gch)), \
          (lds_u32_t*)(smem + (buf_) * 65536 + (wbase + s_) * 1024), 16, 0, 0);                 \
      __builtin_amdgcn_global_load_lds((const unsigned*)(qbse_ + (qs.rowidx(row_) * qld_ + gch)), \
          (lds_u32_t*)(smem + (buf_) * 65536 + 32768 + (wbase + s_) * 1024), 16, 0, 0);         \
    }                                                                                           \
  }
  lds_barrier();
  G_DMA(0, 0)
  asm volatile("s_waitcnt vmcnt(0)" ::: "memory");
  lds_barrier();
  for (int kt = 0; kt < nk; ++kt) {
    if (kt + 1 < nk) { G_DMA(kt + 1, (kt + 1) & 1) }
    gemm_compute(smem + (kt & 1) * 65536, wi, wj, lr, lq, acc);
    asm volatile("s_waitcnt vmcnt(0)" ::: "memory");
    lds_barrier();
  }
#undef G_DMA
}

typedef unsigned u32x2v __attribute__((ext_vector_type(2)));
template <bool SSQ, class PS, class QS, class Epi>
DEV void gemm_tile(const PS& ps, const QS& qs, int K, char* smem, Epi& epi) {
  f32x4 acc[8][4];
  gemm_mainloop(ps, qs, K, smem, acc);
  const int tid = ltid(), lane = tid & 63, wave = tid >> 6;
  const int wi = wave >> 2, wj = wave & 3, lr = lane & 15, lq = lane >> 4;
  if (epi.wide()) {
    const int isub = (lq & 1) ? 16 + (lq - 1) * 4 : lq * 4;
#pragma unroll
    for (int n = 0; n < 4; ++n) {
      const int j = wj * 64 + n * 16 + lr;
      float ss = 0.f;
#pragma unroll
      for (int mp = 0; mp < 4; ++mp) {
        const int ib = wi * 128 + mp * 32;
        const f32x4 va = epi.xform(ib + lq * 4, j, acc[2 * mp][n]);
        const f32x4 vb = epi.xform(ib + 16 + lq * 4, j, acc[2 * mp + 1][n]);
        if (SSQ) ss += va[0] * va[0] + va[1] * va[1] + va[2] * va[2] + va[3] * va[3] + vb[0] * vb[0] + vb[1] * vb[1] + vb[2] * vb[2] + vb[3] * vb[3];
        const unsigned ax = pack2(va[0], va[1]), ay = pack2(va[2], va[3]);
        const unsigned bx = pack2(vb[0], vb[1]), by = pack2(vb[2], vb[3]);
        const u32x2v rx = __builtin_amdgcn_permlane16_swap(ax, bx, false, false);
        const u32x2v ry = __builtin_amdgcn_permlane16_swap(ay, by, false, false);
        const uint4 o = (lq & 1) ? make_uint4(rx[0], ry[0], bx, by) : make_uint4(ax, ay, rx[1], ry[1]);
        epi.store8(ib + isub, j, o);
      }
      if (SSQ) {
        ss = sum_x16(ss);
        ss = sum_x32(ss);
        if (lq == 0) epi.ssq(j, wi, ss);
      }
    }
    return;
  }
#pragma unroll
  for (int n = 0; n < 4; ++n) {
    const int j = wj * 64 + n * 16 + lr;
    float ss = 0.f;
#pragma unroll
    for (int m = 0; m < 8; ++m) {
      const int i = wi * 128 + m * 16 + lq * 4;
      f32x4 v = epi.store(i, j, acc[m][n]);
      if (SSQ) ss += v[0] * v[0] + v[1] * v[1] + v[2] * v[2] + v[3] * v[3];
    }
    if (SSQ) {
      ss = sum_x16(ss);
      ss = sum_x32(ss);
      if (lq == 0) epi.ssq(j, wi, ss);
    }
  }
}

DEV void convert_tile(const float* W, int K, int N, u16* WT, int kt, int nt, char* smem, int drow0 = -1) {
  u16(*t)[72] = (u16(*)[72])(smem + vhalf() * 16384);
  const int tid = vtid();
  __syncthreads();
#pragma unroll
  for (int s = 0; s < 4; ++s) {
    const int k = (tid >> 4) + 16 * s, n4 = (tid & 15) * 4;
    const int gn = nt * 64 + n4;
    float4 v = make_float4(0.f, 0.f, 0.f, 0.f);
    if (gn < N) v = *(const float4*)(W + (size_t)(kt * 64 + k) * N + gn);
    t[n4 + 0][k] = f2bf(v.x); t[n4 + 1][k] = f2bf(v.y); t[n4 + 2][k] = f2bf(v.z); t[n4 + 3][k] = f2bf(v.w);
  }
  __syncthreads();
#pragma unroll
  for (int s = 0; s < 2; ++s) {
    const int n = (tid >> 3) + 32 * s, k8 = (tid & 7) * 8;
    const int gn = nt * 64 + n;
    const int drow = drow0 >= 0 ? drow0 + n : gn;
    if (gn < N) *(uint4*)(WT + (size_t)drow * K + kt * 64 + k8) = *(const uint4*)(&t[n][k8]);
  }
}

DEV void phase_ada_item(const Params& p, int item, char* smem) {
  const int l = item / 48, cc = item % 48, tid = vtid();
  smem += vhalf() * 40960;
  float* sc = (float*)smem;
  __syncthreads();
  for (int e = tid; e < 9 * 1024; e += 256) {
    const int r = e >> 10, k = e & 1023;
    const float v = r < 8 ? p.c[r * 1024 + k] : p.c_ctx[k];
    sc[e] = silu_f(v);
  }
  __syncthreads();
  const int kq = tid >> 5, l32 = tid & 31;
  const int n = cc * 128 + l32 * 4;
  float acc[9][4];
#pragma unroll
  for (int r = 0; r < 9; ++r)
#pragma unroll
    for (int q = 0; q < 4; ++q) acc[r][q] = 0.f;
  const float* W = p.ada_w + (size_t)l * 1024 * 6144 + n;
#pragma unroll 16
  for (int kk = 0; kk < 128; ++kk) {
    const int k = kq * 128 + kk;
    const float4 w = *(const float4*)(W + (size_t)k * 6144);
#pragma unroll
    for (int r = 0; r < 9; ++r) {
      const float s = sc[r * 1024 + k];
      acc[r][0] += s * w.x; acc[r][1] += s * w.y; acc[r][2] += s * w.z; acc[r][3] += s * w.w;
    }
  }
  __syncthreads();
  float* red = (float*)smem;
#pragma unroll
  for (int r = 0; r < 9; ++r)
#pragma unroll
    for (int q = 0; q < 4; ++q) red[(kq * 9 + r) * 128 + l32 * 4 + q] = acc[r][q];
  __syncthreads();
  float* mod = (float*)(p.ws + OFF_MOD);
  for (int e = tid; e < 9 * 128; e += 256) {
    const int r = e / 128, col = e % 128;
    float s = p.ada_b[l * 6144 + cc * 128 + col];
#pragma unroll
    for (int q = 0; q < 8; ++q) s += red[(q * 9 + r) * 128 + col];
    mod[((size_t)l * 9 + r) * 6144 + cc * 128 + col] = s;
  }
}

PHASE_FN void phase0(const Params& p, char* smem, int bid, int nblk) {
  constexpr int N_ADA = 96, N_WIN = 16 * 73, N_WOUT = 24 * 16, N_POOL = 64;
  constexpr int total = N_ADA + N_WIN + N_WOUT + N_POOL;
  if (bid == nblk - 1) {
    uint4* z = (uint4*)((u16*)(p.ws + OFF_WIN) + (size_t)INW * 1024);
    for (int e = ltid(); e < (INWP - INW) * 1024 / 8; e += 512) z[e] = make_uint4(0, 0, 0, 0);
  }
  for (int it2 = bid; it2 < total / 2; it2 += nblk) {
    int id = it2 * 2;
    if (id < N_ADA) { phase_ada_item(p, id + vhalf(), smem); continue; }
    id -= N_ADA;
    if (id < N_WIN) { const int x = id + vhalf(); convert_tile(p.w_in, 1024, INW, (u16*)(p.ws + OFF_WIN), x / 73, x % 73, smem); continue; }
    id -= N_WIN;
    if (id < N_WOUT) { const int x = id + vhalf(); convert_tile(p.w_out, MIXW, 1024, (u16*)(p.ws + OFF_WOUT), x / 16, x % 16, smem); continue; }
    id -= N_WOUT;
    {
      const int x = id + vhalf();
      const int g = x / 16, r = x % 16;
      convert_tile(p.pool_w + (size_t)g * 65536, 256, 256, (u16*)(p.ws + OFF_POOLT) + (size_t)g * 65536, r / 4, r % 4, smem);
    }
  }
}

DEV void ld8f(const float* p, float* v) {
  const float4 a = *(const float4*)p, b = *(const float4*)(p + 4);
  v[0] = a.x; v[1] = a.y; v[2] = a.z; v[3] = a.w; v[4] = b.x; v[5] = b.y; v[6] = b.z; v[7] = b.w;
}
DEV void load_row16(const float* src, int lane, float* v) {
#pragma unroll
  for (int s = 0; s < 4; ++s) {
    const float4 t = *(const float4*)(src + lane * 4 + 256 * s);
    v[s * 4 + 0] = t.x; v[s * 4 + 1] = t.y; v[s * 4 + 2] = t.z; v[s * 4 + 3] = t.w;
  }
}
DEV void norm_mod_store(const float* v, float rstd, const float* g, const float* shift, const float* scale, u16* dst, int lane) {
#pragma unroll
  for (int s = 0; s < 4; ++s) {
    const int c = lane * 4 + 256 * s;
    const float4 gg = *(const float4*)(g + c), sh = *(const float4*)(shift + c), sc = *(const float4*)(scale + c);
    const float h0 = v[s * 4 + 0] * rstd * gg.x * (1.f + sc.x) + sh.x;
    const float h1 = v[s * 4 + 1] * rstd * gg.y * (1.f + sc.y) + sh.y;
    const float h2 = v[s * 4 + 2] * rstd * gg.z * (1.f + sc.z) + sh.z;
    const float h3 = v[s * 4 + 3] * rstd * gg.w * (1.f + sc.w) + sh.w;
    uint2 o; o.x = pack2(h0, h1); o.y = pack2(h2, h3);
    *(uint2*)(dst + c) = o;
  }
}

DEV void norm_in_one(const Params& p, int row, int lane, const float* v) {
  const bool isctx = row >= NTOK;
  const int r = isctx ? row - NTOK : row;
  const int b = isctx ? 8 : r / SEQ;
  float ss = 0.f;
#pragma unroll
  for (int e = 0; e < 16; ++e) ss += v[e] * v[e];
  ss = wave_sum(ss);
  const float rstd = rsqrtf(ss * (1.f / D) + 1e-6f);
  const float* m = (const float*)(p.ws + OFF_MOD) + (size_t)b * 6144;
  u16* dst = isctx ? (u16*)(p.ws + OFF_HC) + (size_t)r * D : (u16*)(p.ws + OFF_HA) + (size_t)r * D;
#pragma unroll
  for (int s = 0; s < 2; ++s) {
    const int c = lane * 8 + 512 * s;
    float g[8], sh[8], sc[8], h[8];
    ld8f(p.norm_g + c, g);
    ld8f(m + c, sh);
    ld8f(m + 1024 + c, sc);
#pragma unroll
    for (int k = 0; k < 8; ++k) h[k] = v[s * 8 + k] * rstd * g[k] * (1.f + sc[k]) + sh[k];
    *(uint4*)(dst + c) = pack8(h);
  }
}

PHASE_FN void phase_norm_in(const Params& p, int bid, int nblk) {
  const int lane = ltid() & 63, gw = bid * 8 + (ltid() >> 6), nw = nblk * 8;
  for (int row = gw; row < NTOK + NCTX; row += 2 * nw) {
    const int row2 = row + nw;
    const bool has2 = row2 < NTOK + NCTX;
    float va[16], vb[16];
    const float* pa = row >= NTOK ? p.ctx + (size_t)(row - NTOK) * D : p.x + (size_t)row * D;
    ld8f(pa + lane * 8, va); ld8f(pa + lane * 8 + 512, va + 8);
    if (has2) {
      const float* pb = row2 >= NTOK ? p.ctx + (size_t)(row2 - NTOK) * D : p.x + (size_t)row2 * D;
      ld8f(pb + lane * 8, vb); ld8f(pb + lane * 8 + 512, vb + 8);
    }
    norm_in_one(p, row, lane, va);
    if (has2) norm_in_one(p, row2, lane, vb);
  }
}

template <bool IN_BF, bool OUT_BF>
PHASE_FN void phase_row_update(const Params& p, int bid, int nblk, const void* xin_, void* xout_, const float* gate_base,
                          const float* gpost, bool has_next, const float* gnext, const float* shift_base,
                          const float* scale_base) {
  const int lane = ltid() & 63, gw = bid * 8 + (ltid() >> 6), nw = nblk * 8;
  const u16* ybuf = (const u16*)(p.ws + OFF_YBUF);
  const float* ssq = (const float*)(p.ws + OFF_SSQ);
  u16* hout = (u16*)(p.ws + OFF_HA);
  float gp[16], gn[16];
#pragma unroll
  for (int s = 0; s < 2; ++s) {
    ld8f(gpost + lane * 8 + 512 * s, gp + s * 8);
    if (has_next) ld8f(gnext + lane * 8 + 512 * s, gn + s * 8);
    else {
#pragma unroll
      for (int k = 0; k < 8; ++k) gn[s * 8 + k] = 0.f;
    }
  }
  constexpr int R = 4;
  for (int row0 = gw; row0 < NTOK; row0 += R * nw) {
    float v[R][16];
    uint4 yy[R][2];
    float sy[R];
#pragma unroll
    for (int j = 0; j < R; ++j) {
      const int row = row0 + j * nw;
#pragma unroll
      for (int s = 0; s < 2; ++s) {
        const int c = lane * 8 + 512 * s;
        if (IN_BF) unpack8(*(const uint4*)((const u16*)xin_ + (size_t)row * D + c), v[j] + s * 8);
        else ld8f((const float*)xin_ + (size_t)row * D + c, v[j] + s * 8);
        yy[j][s] = *(const uint4*)(ybuf + (size_t)row * D + c);
      }
      sy[j] = (lane < 8) ? ssq[(size_t)row * 8 + lane] : 0.f;
    }
#pragma unroll
    for (int j = 0; j < R; ++j) {
      const int row = row0 + j * nw;
      const int b = row / SEQ;
      const float rstd_y = rsqrtf(wave_sum(sy[j]) * (1.f / D) + 1e-6f);
      const float* gate = gate_base + (size_t)b * 6144;
      float ss = 0.f;
#pragma unroll
      for (int s = 0; s < 2; ++s) {
        const int c = lane * 8 + 512 * s;
        float gt[8], yv[8];
        ld8f(gate + c, gt);
        unpack8(yy[j][s], yv);
#pragma unroll
        for (int k = 0; k < 8; ++k) v[j][s * 8 + k] += gt[k] * (yv[k] * rstd_y * gp[s * 8 + k]);
        if (OUT_BF) {
          const uint4 o = pack8(v[j] + s * 8);
          *(uint4*)((u16*)xout_ + (size_t)row * D + c) = o;
          unpack8(o, v[j] + s * 8);
        } else {
          float* xo = (float*)xout_ + (size_t)row * D + c;
          *(float4*)xo = make_float4(v[j][s * 8], v[j][s * 8 + 1], v[j][s * 8 + 2], v[j][s * 8 + 3]);
          *(float4*)(xo + 4) = make_float4(v[j][s * 8 + 4], v[j][s * 8 + 5], v[j][s * 8 + 6], v[j][s * 8 + 7]);
        }
#pragma unroll
        for (int k = 0; k < 8; ++k) ss += v[j][s * 8 + k] * v[j][s * 8 + k];
      }
      if (has_next) {
        const float rstd = rsqrtf(wave_sum(ss) * (1.f / D) + 1e-6f);
        const float* shift = shift_base + (size_t)b * 6144;
        const float* scale = scale_base + (size_t)b * 6144;
#pragma unroll
        for (int s = 0; s < 2; ++s) {
          const int c = lane * 8 + 512 * s;
          float sh[8], sc[8], h[8];
          ld8f(shift + c, sh);
          ld8f(scale + c, sc);
#pragma unroll
          for (int k = 0; k < 8; ++k) h[k] = v[j][s * 8 + k] * rstd * gn[s * 8 + k] * (1.f + sc[k]) + sh[k];
          *(uint4*)(hout + (size_t)row * D + c) = pack8(h);
        }
      }
    }
  }
}

struct TileIter {
  int chunk, local, nx, total, NI, NJ;
  DEV TileIter(int bid, int nblk, int NI_, int NJ_) : chunk(bid & 7), local(bid >> 3), nx(nblk >> 3), total(NI_ * NJ_), NI(NI_), NJ(NJ_) {}
  DEV bool next(int& it, int& jt) {
    const int idp = chunk * nx + local;
    if (chunk * nx >= total) return false;
    chunk += 8;
    if (idp >= total) { it = -1; return true; }
    const int fullp = NJ >> 3;
    const int nfull = fullp * NI * 8;
    if (idp < nfull) {
      const int panel = idp / (NI * 8), rem = idp - panel * (NI * 8);
      it = rem >> 3;
      jt = panel * 8 + (rem & 7);
    } else {
      const int pw = NJ - fullp * 8, rem = idp - nfull;
      it = rem / pw;
      jt = fullp * 8 + (rem - it * pw);
    }
    return true;
  }
};

struct EpiInproj {
  const Params* p; int c0; int t0; bool isctx;
  DEV f32x4 store(int i, int j, f32x4 v) {
    const int c = c0 + i, t = t0 + j;
    char* ws = p->ws;
    uint2 o; o.x = pack2(v[0], v[1]); o.y = pack2(v[2], v[3]);
    if (!isctx) {
      if (c < 512) *(uint2*)((u16*)(ws + OFF_QB) + (size_t)t * 512 + c) = o;
      else if (c < 1536) *(uint2*)((u16*)(ws + OFF_ZB) + (size_t)t * 1024 + (c - 512)) = o;
      else if (c < 2048) *(uint2*)((u16*)(ws + OFF_KB) + (size_t)t * 512 + (c - 1536)) = o;
      else if (c < 2560) *(uint2*)((u16*)(ws + OFF_VB) + (size_t)t * 512 + (c - 2048)) = o;
      else if (c < 4608) {
        *(uint2*)((u16*)(ws + OFF_XBC) + (size_t)t * XBCW + (c - 2560)) = o;
        const int seg = t >> 6, w = t & 63;
        u16* halo = (u16*)(ws + OFF_HALO);
        if (w == 63 && seg + 1 < 512) *(uint2*)(halo + ((size_t)(seg + 1) * 2 + 0) * XBCW + (c - 2560)) = o;
        if (w == 0 && seg > 0) *(uint2*)(halo + ((size_t)(seg - 1) * 2 + 1) * XBCW + (c - 2560)) = o;
      } else if (c < INW) *(float4*)((float*)(ws + OFF_DTRAW) + (size_t)t * 32 + (c - 4608)) = make_float4(v[0], v[1], v[2], v[3]);
    } else {
      if (c < 2048) *(uint2*)((u16*)(ws + OFF_KC) + (size_t)t * 512 + (c - 1536)) = o;
      else if (c < 2560) *(uint2*)((u16*)(ws + OFF_VC) + (size_t)t * 512 + (c - 2048)) = o;
      else if (c < 4608) {
        *(uint2*)((u16*)(ws + OFF_XBCC) + (size_t)t * XBCW + (c - 2560)) = o;
        const int seg = t >> 6, w = t & 63;
        u16* halo = (u16*)(ws + OFF_HALO) + (size_t)512 * 2 * XBCW;
        if (w == 63 && seg + 1 < 32) *(uint2*)(halo + ((size_t)(seg + 1) * 2 + 0) * XBCW + (c - 2560)) = o;
        if (w == 0 && seg > 0) *(uint2*)(halo + ((size_t)(seg - 1) * 2 + 1) * XBCW + (c - 2560)) = o;
      } else if (c < INW) *(float4*)((float*)(ws + OFF_DTRAWC) + (size_t)t * 32 + (c - 4608)) = make_float4(v[0], v[1], v[2], v[3]);
    }
    return v;
  }
  DEV void ssq(int, int, float) {}
  DEV bool wide() const { return c0 + 256 <= 4608; }
  DEV f32x4 xform(int, int, f32x4 v) const { return v; }
  DEV void store8(int i8, int j, uint4 o) {
    const int c = c0 + i8, t = t0 + j;
    char* ws = p->ws;
    if (!isctx) {
      if (c < 512) nt_store16((u16*)(ws + OFF_QB) + (size_t)t * 512 + c, o);
      else if (c < 1536) nt_store16((u16*)(ws + OFF_ZB) + (size_t)t * 1024 + (c - 512), o);
      else if (c < 2048) nt_store16((u16*)(ws + OFF_KB) + (size_t)t * 512 + (c - 1536), o);
      else if (c < 2560) nt_store16((u16*)(ws + OFF_VB) + (size_t)t * 512 + (c - 2048), o);
      else {
        nt_store16((u16*)(ws + OFF_XBC) + (size_t)t * XBCW + (c - 2560), o);
        const int seg = t >> 6, w = t & 63;
        u16* halo = (u16*)(ws + OFF_HALO);
        if (w == 63 && seg + 1 < 512) *(uint4*)(halo + ((size_t)(seg + 1) * 2 + 0) * XBCW + (c - 2560)) = o;
        if (w == 0 && seg > 0) *(uint4*)(halo + ((size_t)(seg - 1) * 2 + 1) * XBCW + (c - 2560)) = o;
      }
    } else {
      if (c < 2048) *(uint4*)((u16*)(ws + OFF_KC) + (size_t)t * 512 + (c - 1536)) = o;
      else if (c < 2560) *(uint4*)((u16*)(ws + OFF_VC) + (size_t)t * 512 + (c - 2048)) = o;
      else {
        *(uint4*)((u16*)(ws + OFF_XBCC) + (size_t)t * XBCW + (c - 2560)) = o;
        const int seg = t >> 6, w = t & 63;
        u16* halo = (u16*)(ws + OFF_HALO) + (size_t)512 * 2 * XBCW;
        if (w == 63 && seg + 1 < 32) *(uint4*)(halo + ((size_t)(seg + 1) * 2 + 0) * XBCW + (c - 2560)) = o;
        if (w == 0 && seg > 0) *(uint4*)(halo + ((size_t)(seg - 1) * 2 + 1) * XBCW + (c - 2560)) = o;
      }
    }
  }
};

PHASE_FN void phase_inproj(const Params& p, char* smem, int bid, int nblk) {
  constexpr int NI = INWP / 256, NJ = NTOK / 256, NIC = (INWP - 1536) / 256, NJC = NCTX / 256;
  const int total = NI * NJ + NIC * NJC;
  const u16* WinT = (const u16*)(p.ws + OFF_WIN);
  {
    TileIter ti(bid, nblk, NI, NJ);
    int it, jt;
    while (ti.next(it, jt)) {
      if (it < 0) continue;
      SrcPlain ps{WinT + (size_t)it * 256 * 1024, 1024};
      SrcPlain qs{(const u16*)(p.ws + OFF_HA) + (size_t)jt * 256 * 1024, 1024};
      EpiInproj epi{&p, it * 256, jt * 256, false};
      gemm_tile<false>(ps, qs, 1024, smem, epi);
    }
  }
  for (int id = NI * NJ + bid; id < total; id += nblk) {
    const int id2 = id - NI * NJ;
    const int it = id2 % NIC, jt = id2 / NIC;
    SrcPlain ps{WinT + (size_t)(1536 + it * 256) * 1024, 1024};
    SrcPlain qs{(const u16*)(p.ws + OFF_HC) + (size_t)jt * 256 * 1024, 1024};
    EpiInproj epi{&p, 1536 + it * 256, jt * 256, true};
    gemm_tile<false>(ps, qs, 1024, smem, epi);
  }
}

DEV void transpose_v_tile(const u16* src, u16* dst, int L, char* smem) {
  u16(*t)[72] = (u16(*)[72])(smem + vhalf() * 16384);
  const int tid = vtid();
  __syncthreads();
  {
    const int row = tid >> 2, c16 = (tid & 3) * 16;
    const uint4 a = *(const uint4*)(src + (size_t)row * 512 + c16);
    const uint4 b = *(const uint4*)(src + (size_t)row * 512 + c16 + 8);
    *(uint4*)(&t[row][c16]) = a;
    *(uint4*)(&t[row][c16 + 8]) = b;
  }
  __syncthreads();
  {
    const int d = tid >> 2, t16 = (tid & 3) * 16;
    unsigned o[8];
#pragma unroll
    for (int e = 0; e < 8; ++e) o[e] = (unsigned)t[t16 + 2 * e][d] | ((unsigned)t[t16 + 2 * e + 1][d] << 16);
    *(uint4*)(dst + (size_t)d * L + t16) = make_uint4(o[0], o[1], o[2], o[3]);
    *(uint4*)(dst + (size_t)d * L + t16 + 8) = make_uint4(o[4], o[5], o[6], o[7]);
  }
}

PHASE_FN void phase_conv(const Params& p, char* smem, int bid, int nblk) {
  const int tid = vtid();
  const int c8 = tid * 8;
  constexpr int NSEG = 512 + 32, NVT = 4096, NVCT = 256;
  unsigned* qc = (unsigned*)(p.ws + OFF_CNT) + 18;
  int* shq = (int*)(smem + 140000);
  for (;;) {
    __syncthreads();
    if (ltid() == 0) *shq = (int)atomicAdd(qc, 1u);
    __syncthreads();
    const int it2 = *shq;
    if (it2 >= (NSEG + NVT + NVCT) / 2) break;
    const int it = it2 * 2 + vhalf();
    if (it >= NSEG) {
      int id = it - NSEG;
      if (id < NVT) {
        const int tt = id & 63, h = (id >> 6) & 7, b = id >> 9;
        transpose_v_tile((const u16*)(p.ws + OFF_VB) + ((size_t)b * SEQ + tt * 64) * 512 + h * 64,
                         (u16*)(p.ws + OFF_VT) + ((size_t)(b * 8 + h) * 64) * SEQ + tt * 64, SEQ, smem);
      } else {
        id -= NVT;
        const int tt = id & 3, h = (id >> 2) & 7, b = id >> 5;
        transpose_v_tile((const u16*)(p.ws + OFF_VC) + ((size_t)b * CTXL + tt * 64) * 512 + h * 64,
                         (u16*)(p.ws + OFF_VCT) + ((size_t)(b * 8 + h) * 64) * CTXL + tt * 64, CTXL, smem);
      }
      continue;
    }
    const int seg = it;
    float w0[8], w1[8], w2[8], bb[8];
#pragma unroll
    for (int e = 0; e < 8; ++e) {
      w0[e] = p.conv_w[c8 + e]; w1[e] = p.conv_w[XBCW + c8 + e]; w2[e] = p.conv_w[2 * XBCW + c8 + e]; bb[e] = p.conv_b[c8 + e];
    }
    const bool isctx = seg >= 512;
    const int sl = isctx ? seg - 512 : seg;
    u16* base = (isctx ? (u16*)(p.ws + OFF_XBCC) : (u16*)(p.ws + OFF_XBC)) + (size_t)sl * 64 * XBCW + c8;
    const u16* halo = (const u16*)(p.ws + OFF_HALO) + (size_t)seg * 2 * XBCW + c8;
    const int L = isctx ? CTXL : SEQ;
    const int tin0 = (sl * 64) % L;
    uint4 prevraw = make_uint4(0, 0, 0, 0);
    if (tin0 != 0) prevraw = *(const uint4*)(halo);
    uint4 lastraw = make_uint4(0, 0, 0, 0);
    if (tin0 + 64 != L) lastraw = *(const uint4*)(halo + XBCW);
    for (int sb = 0; sb < 8; ++sb) {
      uint4 raw[9];
#pragma unroll
      for (int r = 0; r < 8; ++r) raw[r] = *(const uint4*)(base + (size_t)(sb * 8 + r) * XBCW);
      raw[8] = (sb < 7) ? *(const uint4*)(base + (size_t)(sb * 8 + 8) * XBCW) : lastraw;
      float prev[8], cur[8], nxt[8];
      unpack8(prevraw, prev);
      unpack8(raw[0], cur);
#pragma unroll
      for (int r = 0; r < 8; ++r) {
        unpack8(raw[r + 1], nxt);
        float o[8];
#pragma unroll
        for (int e = 0; e < 8; ++e) o[e] = silu_f(w0[e] * prev[e] + w1[e] * cur[e] + w2[e] * nxt[e] + bb[e]);
        *(uint4*)(base + (size_t)(sb * 8 + r) * XBCW) = pack8(o);
#pragma unroll
        for (int e = 0; e < 8; ++e) { prev[e] = cur[e]; cur[e] = nxt[e]; }
      }
      prevraw = raw[7];
    }
  }
}

DEV void ssd_naive_item(const Params& p, int item, char* smem) {
  const int tid = ltid();
  const int dir = item & 1, h = (item >> 1) & 15, b = item >> 5;
  const int g = h >> 2;
  const int pp = tid >> 2, nq = tid & 3;
  const float A = __expf(p.a_log[dir * 16 + h]);
  const float dtb = p.dt_bias[dir * 16 + h];
  float st[32];
#pragma unroll
  for (int e = 0; e < 32; ++e) st[e] = 0.f;
  u16* sx = (u16*)smem;
  float* sdt = (float*)(smem + 32 * 640);
  u16* Yd = (u16*)(p.ws + (dir ? OFF_Y1 : OFF_Y0));
  for (int part = 0; part < 2; ++part) {
    const int L = part == 0 ? CTXL : SEQ;
    const u16* xb = part == 0 ? (const u16*)(p.ws + OFF_XBCC) + (size_t)b * CTXL * XBCW
                              : (const u16*)(p.ws + OFF_XBC) + (size_t)b * SEQ * XBCW;
    const float* dtr = part == 0 ? (const float*)(p.ws + OFF_DTRAWC) + (size_t)b * CTXL * 32
                                 : (const float*)(p.ws + OFF_DTRAW) + (size_t)b * SEQ * 32;
    for (int s0 = 0; s0 < L; s0 += 32) {
      __syncthreads();
      for (int e = tid; e < 32 * 40; e += 256) {
        const int s = e / 40, ch = e % 40;
        const int t = dir ? (L - 1 - (s0 + s)) : (s0 + s);
        const u16* row = xb + (size_t)t * XBCW;
        const u16* src = ch < 8 ? row + h * 64 + ch * 8 : (ch < 24 ? row + 1024 + g * 128 + (ch - 8) * 8 : row + 1536 + g * 128 + (ch - 24) * 8);
        *(uint4*)(sx + s * 320 + ch * 8) = *(const uint4*)src;
      }
      if (tid < 32) {
        const int t = dir ? (L - 1 - (s0 + tid)) : (s0 + tid);
        const float dt = softplus_f(dtr[(size_t)t * 32 + dir * 16 + h] + dtb);
        sdt[tid] = dt;
        sdt[32 + tid] = __expf(-dt * A);
      }
      __syncthreads();
      for (int s = 0; s < 32; ++s) {
        const float dt = sdt[s], dec = sdt[32 + s];
        const float xdt = bf2f(sx[s * 320 + pp]) * dt;
        float y = 0.f;
        const u16* Bp = sx + s * 320 + 64 + nq * 32;
        const u16* Cp = sx + s * 320 + 192 + nq * 32;
#pragma unroll
        for (int q = 0; q < 4; ++q) {
          float bv[8], cv[8];
          unpack8(*(const uint4*)(Bp + q * 8), bv);
          unpack8(*(const uint4*)(Cp + q * 8), cv);
#pragma unroll
          for (int e = 0; e < 8; ++e) {
            st[q * 8 + e] = st[q * 8 + e] * dec + bv[e] * xdt;
            y += cv[e] * st[q * 8 + e];
          }
        }
        if (part == 1) {
          y += __shfl_xor(y, 1);
          y += __shfl_xor(y, 2);
          if (nq == 0) {
            const int t = dir ? (L - 1 - (s0 + s)) : (s0 + s);
            Yd[((size_t)b * SEQ + t) * 1024 + h * 64 + pp] = f2bf(y);
          }
        }
      }
    }
  }
}

DEV void ssd_mfma_item(const Params& p, int item, char* smem) {
  const int tid = vtid(), lane = tid & 63, w = tid >> 6, lr = lane & 15, lq = lane >> 4;
  smem += vhalf() * 69632;
  const int dir = item & 1, h = (item >> 1) & 15, b = item >> 5, g = h >> 2;
  const float A = __expf(p.a_log[dir * 16 + h]);
  const float dtb = p.dt_bias[dir * 16 + h];
  char* Bs = smem;
  char* Ss0 = smem + 16384;
  char* Xd = smem + 32768;
  char* Xw = smem + 40960;
  float* acs = (float*)(smem + 49152);
  float* sdt = acs + 64;
  float* sw = acs + 128;
  float* se = acs + 192;
  f32x4 S[2][4];
#pragma unroll
  for (int i = 0; i < 2; ++i)
#pragma unroll
    for (int pt = 0; pt < 4; ++pt) S[i][pt] = f32x4{0.f, 0.f, 0.f, 0.f};
  u16* Yd = (u16*)(p.ws + (dir ? OFF_Y1 : OFF_Y0));
  const int trq = lr >> 2, trp = lr & 3;
  const int trrow = lq * 4 + trq;
  const int sw1 = ((trrow >> 1) & 3) << 1, sw2 = (trrow & 7) << 1, sw3 = (lr & 7) << 1;
  const int xoff0 = trrow * 128 + (((0 + (trp >> 1)) ^ sw1) << 4) + 8 * (trp & 1);
  const int xoff1 = trrow * 128 + (((2 + (trp >> 1)) ^ sw1) << 4) + 8 * (trp & 1);
  const int xoff2 = trrow * 128 + (((4 + (trp >> 1)) ^ sw1) << 4) + 8 * (trp & 1);
  const int xoff3 = trrow * 128 + (((6 + (trp >> 1)) ^ sw1) << 4) + 8 * (trp & 1);
  const int boffA = trrow * 256 + ((((2 * w) * 2 + (trp >> 1)) ^ sw2) << 4) + 8 * (trp & 1);
  const int boffB = trrow * 256 + ((((2 * w + 1) * 2 + (trp >> 1)) ^ sw2) << 4) + 8 * (trp & 1);
  const int roff0 = lr * 256 + (((0 + lq) ^ sw3) << 4), roff1 = lr * 256 + (((4 + lq) ^ sw3) << 4);
  const int roff2 = lr * 256 + (((8 + lq) ^ sw3) << 4), roff3 = lr * 256 + (((12 + lq) ^ sw3) << 4);
  const int woffA = lr * 256 + ((((2 * w) * 2 + (lq >> 1)) ^ sw3) << 4) + 8 * (lq & 1);
  const int woffB = lr * 256 + ((((2 * w + 1) * 2 + (lq >> 1)) ^ sw3) << 4) + 8 * (lq & 1);
#define XOFF(pt_) ((pt_) == 0 ? xoff0 : (pt_) == 1 ? xoff1 : (pt_) == 2 ? xoff2 : xoff3)
#define ROFF(ks_) ((ks_) == 0 ? roff0 : (ks_) == 1 ? roff1 : (ks_) == 2 ? roff2 : roff3)
#define TMAPX(tb_, s_) (dir ? ((tb_) + 63 - (s_)) : ((tb_) + (s_)))
#define CH_ISCTX(c_) ((c_) < 4)
#define CH_TBASE(c_) (CH_ISCTX(c_) ? (dir ? (CTXL - 64 - (c_) * 64) : (c_) * 64) : (dir ? (SEQ - 64 - ((c_) - 4) * 64) : ((c_) - 4) * 64))
#define CH_XB(c_) (CH_ISCTX(c_) ? (const u16*)(p.ws + OFF_XBCC) + (size_t)b * CTXL * XBCW : (const u16*)(p.ws + OFF_XBC) + (size_t)b * SEQ * XBCW)
#define CH_DTR(c_) (CH_ISCTX(c_) ? (const float*)(p.ws + OFF_DTRAWC) + (size_t)b * CTXL * 32 : (const float*)(p.ws + OFF_DTRAW) + (size_t)b * SEQ * 32)
#define SSD_OFF(t_, col_) ((unsigned)(((t_) * XBCW + (col_)) * 2))
#define SSD_LOAD(c_)                                                                                        \
  {                                                                                                         \
    const char* xb_ = (const char*)(CH_XB(c_)); const int tb_ = CH_TBASE(c_);                               \
    xr0 = *(const uint4*)(xb_ + SSD_OFF(TMAPX(tb_, (tid >> 3)), h * 64 + (tid & 7) * 8));                   \
    xr1 = *(const uint4*)(xb_ + SSD_OFF(TMAPX(tb_, (tid >> 3) + 32), h * 64 + (tid & 7) * 8));              \
    br0 = *(const uint4*)(xb_ + SSD_OFF(TMAPX(tb_, (tid >> 4)), 1024 + g * 128 + (tid & 15) * 8));          \
    br1 = *(const uint4*)(xb_ + SSD_OFF(TMAPX(tb_, (tid >> 4) + 16), 1024 + g * 128 + (tid & 15) * 8));     \
    br2 = *(const uint4*)(xb_ + SSD_OFF(TMAPX(tb_, (tid >> 4) + 32), 1024 + g * 128 + (tid & 15) * 8));     \
    br3 = *(const uint4*)(xb_ + SSD_OFF(TMAPX(tb_, (tid >> 4) + 48), 1024 + g * 128 + (tid & 15) * 8));     \
    if (!CH_ISCTX(c_)) {                                                                                    \
      const char* crow_ = xb_ + SSD_OFF(TMAPX(tb_, w * 16 + lr), 1536 + g * 128 + lq * 8);                  \
      cfn0 = *(const bf16x8*)(crow_); cfn1 = *(const bf16x8*)(crow_ + 64);                                  \
      cfn2 = *(const bf16x8*)(crow_ + 128); cfn3 = *(const bf16x8*)(crow_ + 192);                           \
    }                                                                                                       \
    dtn = *(const float*)((const char*)(CH_DTR(c_)) + (unsigned)((TMAPX(tb_, lane) * 32 + dir * 16 + h) * 4)); \
  }
  uint4 xr0, xr1, br0, br1, br2, br3;
  bf16x8 cfn0 = {}, cfn1 = {}, cfn2 = {}, cfn3 = {};
  float dtn = 0.f;
  SSD_LOAD(0)
  for (int ch = 0; ch < 68; ++ch) {
    const bool isctx = ch < 4;
    const int tbase = CH_TBASE(ch);
#define TMAP(s_) TMAPX(tbase, s_)
    bf16x8 cf[4];
    cf[0] = cfn0; cf[1] = cfn1; cf[2] = cfn2; cf[3] = cfn3;
    const float dtraw_cur = dtn;
    const float dt_l = softplus_f(dtraw_cur + dtb);
    float cs_l = -dt_l * A;
#pragma unroll
    for (int o = 1; o < 64; o <<= 1) {
      const float t = __shfl_up(cs_l, o);
      if (lane >= o) cs_l += t;
    }
    const float tot_l = __shfl(cs_l, 63);
    const float w_l = __expf(tot_l - cs_l), e_l = __expf(cs_l);
    const float dec = __shfl(e_l, 63);
    char* SsR = Ss0 + (ch & 1) * 36864;
    char* SsW = Ss0 + ((ch + 1) & 1) * 36864;
    lds_barrier();
    if (w == 0) { acs[lane] = cs_l; se[lane] = e_l; }
#define SSD_XST(XR, i_)                                                      \
    {                                                                        \
      const int s_ = (tid >> 3) + 32 * (i_), c = tid & 7;                    \
      float f[8], fw[8];                                                     \
      unpack8(XR, f);                                                        \
      const float d = __shfl(dt_l, s_), ww = __shfl(w_l, s_);                \
      _Pragma("unroll") for (int e = 0; e < 8; ++e) { f[e] *= d; fw[e] = f[e] * ww; } \
      const int off = s_ * 128 + ((c ^ (((s_ >> 1) & 3) << 1)) << 4);        \
      *(uint4*)(Xd + off) = pack8(f);                                        \
      *(uint4*)(Xw + off) = pack8(fw);                                       \
    }
    SSD_XST(xr0, 0) SSD_XST(xr1, 1)
#undef SSD_XST
#define SSD_BST(BR, i_) { const int s_ = (tid >> 4) + 16 * (i_), c = tid & 15; *(uint4*)(Bs + s_ * 256 + ((c ^ ((s_ & 7) << 1)) << 4)) = BR; }
    SSD_BST(br0, 0) SSD_BST(br1, 1) SSD_BST(br2, 2) SSD_BST(br3, 3)
#undef SSD_BST
    lds_barrier();
    if (ch + 1 < 68) { SSD_LOAD(ch + 1) }
    if (!isctx) {
      f32x4 G[4];
      {
        bf16x8 ga[4][4];
#pragma unroll
        for (int j = 0; j < 4; ++j)
#pragma unroll
          for (int ks = 0; ks < 4; ++ks) ga[j][ks] = *(const bf16x8*)(Bs + j * 4096 + ROFF(ks));
        const float la = acs[w * 16 + lr];
        float4 sa4[4];
#pragma unroll
        for (int j = 0; j < 4; ++j) sa4[j] = *(const float4*)(acs + j * 16 + lq * 4);
        __builtin_amdgcn_sched_barrier(0);
#pragma unroll
        for (int j = 0; j < 4; ++j) {
          G[j] = f32x4{0.f, 0.f, 0.f, 0.f};
          if (j <= w) {
#pragma unroll
            for (int ks = 0; ks < 4; ++ks) G[j] = __builtin_amdgcn_mfma_f32_16x16x32_bf16(ga[j][ks], cf[ks], G[j], 0, 0, 0);
          }
        }
#pragma unroll
        for (int j = 0; j < 4; ++j) {
          if (j <= w) {
            const float sv[4] = {sa4[j].x, sa4[j].y, sa4[j].z, sa4[j].w};
#pragma unroll
            for (int r = 0; r < 4; ++r) {
              const bool keep = (j < w) || (lq * 4 + r <= lr);
              const float ev = __expf(fminf(la - sv[r], 0.f));
              G[j][r] = keep ? G[j][r] * ev : 0.f;
            }
          }
        }
      }
      bf16x8 Mf[2];
#pragma unroll
      for (int kk = 0; kk < 2; ++kk) {
        const unsigned u0 = pack2(G[2 * kk][0], G[2 * kk][1]), u1 = pack2(G[2 * kk][2], G[2 * kk][3]);
        const unsigned u2 = pack2(G[2 * kk + 1][0], G[2 * kk + 1][1]), u3 = pack2(G[2 * kk + 1][2], G[2 * kk + 1][3]);
        const uint4 u = make_uint4(u0, u1, u2, u3);
        Mf[kk] = __builtin_bit_cast(bf16x8, u);
      }
      f32x4 Y[4];
      const float4 evv = *(const float4*)(se + w * 16 + lq * 4);
      {
        bf16x8 sb[4][4];
#pragma unroll
        for (int pt = 0; pt < 4; ++pt)
#pragma unroll
          for (int ks = 0; ks < 4; ++ks) sb[pt][ks] = *(const bf16x8*)(SsR + pt * 4096 + ROFF(ks));
        __builtin_amdgcn_sched_barrier(0);
#pragma unroll
        for (int pt = 0; pt < 4; ++pt) {
          Y[pt] = f32x4{0.f, 0.f, 0.f, 0.f};
#pragma unroll
          for (int ks = 0; ks < 4; ++ks) Y[pt] = __builtin_amdgcn_mfma_f32_16x16x32_bf16(cf[ks], sb[pt][ks], Y[pt], 0, 0, 0);
          Y[pt][0] *= evv.x; Y[pt][1] *= evv.y; Y[pt][2] *= evv.z; Y[pt][3] *= evv.w;
        }
      }
      {
        s16x4 xt[2][4][2];
#pragma unroll
        for (int kk = 0; kk < 2; ++kk)
#pragma unroll
          for (int pt = 0; pt < 4; ++pt) {
            xt[kk][pt][0] = lds_tr(Xd + kk * 4096 + XOFF(pt));
            xt[kk][pt][1] = lds_tr(Xd + kk * 4096 + 2048 + XOFF(pt));
          }
        __builtin_amdgcn_sched_barrier(0);
#pragma unroll
        for (int kk = 0; kk < 2; ++kk) {
          if (kk * 2 <= w) {
#pragma unroll
            for (int pt = 0; pt < 4; ++pt)
              Y[pt] = __builtin_amdgcn_mfma_f32_16x16x32_bf16(Mf[kk], cat4(xt[kk][pt][0], xt[kk][pt][1]), Y[pt], 0, 0, 0);
          }
        }
      }
      {
        const int tq = TMAP(w * 16 + lq * 4 + (lr & 3));
        u16* yrow = Yd + ((size_t)b * SEQ + tq) * 1024 + h * 64 + (lr & 12);
#pragma unroll
        for (int pt = 0; pt < 4; ++pt) {
          float v0 = Y[pt][0], v1 = Y[pt][1], v2 = Y[pt][2], v3 = Y[pt][3];
          {
            const float s0 = (lane & 1) ? v0 : v1, s1 = (lane & 1) ? v2 : v3;
            const float r0 = __shfl_xor(s0, 1), r1 = __shfl_xor(s1, 1);
            if (lane & 1) { v0 = r0; v2 = r1; } else { v1 = r0; v3 = r1; }
          }
          {
            const float s0 = (lane & 2) ? v0 : v2, s1 = (lane & 2) ? v1 : v3;
            const float r0 = __shfl_xor(s0, 2), r1 = __shfl_xor(s1, 2);
            if (lane & 2) { v0 = r0; v1 = r1; } else { v2 = r0; v3 = r1; }
          }
          uint2 o; o.x = pack2(v0, v1); o.y = pack2(v2, v3);
          *(uint2*)(yrow + pt * 16) = o;
        }
      }
    }
    {
#pragma unroll
      for (int i = 0; i < 2; ++i)
#pragma unroll
        for (int pt = 0; pt < 4; ++pt) { S[i][pt][0] *= dec; S[i][pt][1] *= dec; S[i][pt][2] *= dec; S[i][pt][3] *= dec; }
      {
        s16x4 xw[2][4][2], bt[2][2][2];
#pragma unroll
        for (int k2 = 0; k2 < 2; ++k2) {
#pragma unroll
          for (int pt = 0; pt < 4; ++pt) {
            xw[k2][pt][0] = lds_tr(Xw + k2 * 4096 + XOFF(pt));
            xw[k2][pt][1] = lds_tr(Xw + k2 * 4096 + 2048 + XOFF(pt));
          }
          bt[k2][0][0] = lds_tr(Bs + k2 * 8192 + boffA);
          bt[k2][0][1] = lds_tr(Bs + k2 * 8192 + 4096 + boffA);
          bt[k2][1][0] = lds_tr(Bs + k2 * 8192 + boffB);
          bt[k2][1][1] = lds_tr(Bs + k2 * 8192 + 4096 + boffB);
        }
        __builtin_amdgcn_sched_barrier(0);
#pragma unroll
        for (int k2 = 0; k2 < 2; ++k2)
#pragma unroll
          for (int i = 0; i < 2; ++i) {
            const bf16x8 af = cat4(bt[k2][i][0], bt[k2][i][1]);
#pragma unroll
            for (int pt = 0; pt < 4; ++pt)
              S[i][pt] = __builtin_amdgcn_mfma_f32_16x16x32_bf16(af, cat4(xw[k2][pt][0], xw[k2][pt][1]), S[i][pt], 0, 0, 0);
          }
      }
#pragma unroll
      for (int i = 0; i < 2; ++i)
#pragma unroll
        for (int pt = 0; pt < 4; ++pt) {
          uint2 o; o.x = pack2(S[i][pt][0], S[i][pt][1]); o.y = pack2(S[i][pt][2], S[i][pt][3]);
          *(uint2*)(SsW + pt * 4096 + (i == 0 ? woffA : woffB)) = o;
        }
    }
#undef TMAP
  }
#undef SSD_LOAD
#undef SSD_OFF
#undef XOFF
#undef ROFF
#undef CH_DTR
#undef CH_XB
#undef CH_TBASE
#undef CH_ISCTX
#undef TMAPX
  __syncthreads();
}

DEV void attn_naive(const Params& p, int gw, int nw) {
  const int lane = ltid() & 63;
  u16* Qb = (u16*)(p.ws + OFF_QB);
  const u16* Kb = (const u16*)(p.ws + OFF_KB);
  const u16* Vb = (const u16*)(p.ws + OFF_VB);
  const u16* Kc = (const u16*)(p.ws + OFF_KC);
  const u16* Vc = (const u16*)(p.ws + OFF_VC);
  for (int pair = gw; pair < NTOK * 8; pair += nw) {
    const int token = pair >> 3, h = pair & 7;
    const int b = token / SEQ, t = token % SEQ, r = t >> 6, qc = t & 63;
    const int rs = min(max(r - 4, 0), 56), cs = min(max(qc - 8, 0), 48);
    const float qv = bf2f(Qb[(size_t)token * 512 + h * 64 + lane]);
    float sc[6];
    const u16* kptr[6];
#pragma unroll
    for (int s = 0; s < 6; ++s) {
      const int kk = lane + 64 * s;
      if (s < 2) {
        const int wr = kk >> 4, wc = kk & 15;
        const int kt = b * SEQ + (rs + wr) * 64 + cs + wc;
        kptr[s] = Kb + (size_t)kt * 512 + h * 64;
        sc[s] = p.na_rpb[(h * 15 + (rs + wr - r + 7)) * 31 + (cs + wc - qc + 15)];
      } else {
        kptr[s] = Kc + (size_t)(b * CTXL + kk - 128) * 512 + h * 64;
        sc[s] = 0.f;
      }
    }
    float dot[6] = {0.f, 0.f, 0.f, 0.f, 0.f, 0.f};
#pragma unroll
    for (int d8 = 0; d8 < 8; ++d8) {
      float qd[8];
#pragma unroll
      for (int e = 0; e < 8; ++e) qd[e] = __shfl(qv, d8 * 8 + e);
#pragma unroll
      for (int s = 0; s < 6; ++s) {
        float kv[8];
        unpack8(*(const uint4*)(kptr[s] + d8 * 8), kv);
#pragma unroll
        for (int e = 0; e < 8; ++e) dot[s] += qd[e] * kv[e];
      }
    }
    float m = -1e30f;
#pragma unroll
    for (int s = 0; s < 6; ++s) { sc[s] += dot[s] * 0.125f; m = fmaxf(m, sc[s]); }
    m = wave_max(m);
    float sum = 0.f;
#pragma unroll
    for (int s = 0; s < 6; ++s) { sc[s] = __expf(sc[s] - m); sum += sc[s]; }
    sum = wave_sum(sum);
    float o = 0.f;
#pragma unroll
    for (int s = 0; s < 6; ++s) {
      for (int src = 0; src < 64; ++src) {
        const float pv = __shfl(sc[s], src);
        const int kk = src + 64 * s;
        const u16* vp;
        if (s < 2) {
          const int wr = kk >> 4, wc = kk & 15;
          vp = Vb + (size_t)(b * SEQ + (rs + wr) * 64 + cs + wc) * 512 + h * 64;
        } else vp = Vc + (size_t)(b * CTXL + kk - 128) * 512 + h * 64;
        o += pv * bf2f(vp[lane]);
      }
    }
    Qb[(size_t)token * 512 + h * 64 + lane] = f2bf(o / sum);
  }
}

DEV void attn_mfma_unit(const Params& p, int bu, char* smem) {
  const int tid = vtid(), lane = tid & 63, w = tid >> 6, lr = lane & 15, lq = lane >> 4;
  smem += vhalf() * 36864;
  const int r = bu & 63, h = (bu >> 6) & 7, b = bu >> 9;
  const int q0 = w * 16, kc0 = min(max(q0 - 8, 0), 32), rs = min(max(r - 4, 0), 56);
  const int qcol = q0 + lr, cs = min(max(qcol - 8, 0), 48);
  u16* Qb = (u16*)(p.ws + OFF_QB);
  const size_t qtok = (size_t)b * SEQ + r * 64 + qcol;
  bf16x8 qf[2];
  qf[0] = *(const bf16x8*)(Qb + qtok * 512 + h * 64 + lq * 8);
  qf[1] = *(const bf16x8*)(Qb + qtok * 512 + h * 64 + 32 + lq * 8);
  f32x4 O[4];
#pragma unroll
  for (int dt = 0; dt < 4; ++dt) O[dt] = f32x4{0.f, 0.f, 0.f, 0.f};
  float m = -1e30f, lsum = 0.f;
  const float LOG2E = 1.44269504089f;
  const float sc = 0.125f * LOG2E;
  const float* rpb = p.na_rpb + h * 15 * 31;
  const int koff0 = (lr >> 2) * 8 + (lr & 3), koff1 = koff0 + 4;
  int bcol[8];
  bool bval[8];
#pragma unroll
  for (int e = 0; e < 8; ++e) {
    const int kc = kc0 + lq * 8 + e;
    bval[e] = (unsigned)(kc - cs) < 16u;
    bcol[e] = bval[e] ? (kc - qcol + 15) : 0;
  }
  const int srow = tid >> 2, sc0 = (tid & 3) * 2;
  const u16* Kb = (const u16*)(p.ws + OFF_KB) + ((size_t)b * SEQ * 512 + h * 64);
  const u16* Kc = (const u16*)(p.ws + OFF_KC) + ((size_t)b * CTXL * 512 + h * 64);
  const u16* VT = (const u16*)(p.ws + OFF_VT) + ((size_t)(b * 8 + h) * 64 + srow) * SEQ;
  const u16* VcT = (const u16*)(p.ws + OFF_VCT) + ((size_t)(b * 8 + h) * 64 + srow) * CTXL;
  uint4 sk0A, sk1A, sv0A, sv1A, sk0B, sk1B, sv0B, sv1B, sk0C, sk1C, sv0C, sv1C;
#define AT_LOAD(st_, S)                                                                         \
  {                                                                                             \
    if ((st_) < 8) {                                                                            \
      const u16* kp_ = Kb + (size_t)((rs + (st_)) * 64 + srow) * 512 + sc0 * 8;                 \
      const u16* vp_ = VT + (rs + (st_)) * 64 + sc0 * 8;                                        \
      sk0##S = *(const uint4*)kp_; sk1##S = *(const uint4*)(kp_ + 8);                           \
      sv0##S = *(const uint4*)vp_; sv1##S = *(const uint4*)(vp_ + 8);                           \
    } else {                                                                                    \
      const u16* kp_ = Kc + (size_t)(((st_) - 8) * 64 + srow) * 512 + sc0 * 8;                  \
      const u16* vp_ = VcT + ((st_) - 8) * 64 + sc0 * 8;                                        \
      sk0##S = *(const uint4*)kp_; sk1##S = *(const uint4*)(kp_ + 8);                           \
      sv0##S = *(const uint4*)vp_; sv1##S = *(const uint4*)(vp_ + 8);                           \
    }                                                                                           \
  }
#define AT_STORE(buf_, S)                                                                       \
  {                                                                                             \
    char* kb_ = smem + (buf_) * 16384 + srow * 128;                                             \
    *(uint4*)(kb_ + (((sc0) ^ (srow & 7)) << 4)) = sk0##S;                                      \
    *(uint4*)(kb_ + (((sc0 + 1) ^ (srow & 7)) << 4)) = sk1##S;                                  \
    *(uint4*)(kb_ + 8192 + (((sc0) ^ (srow & 7)) << 4)) = sv0##S;                               \
    *(uint4*)(kb_ + 8192 + (((sc0 + 1) ^ (srow & 7)) << 4)) = sv1##S;                           \
  }
#define AT_PAIR(islat_, st_, cb_, buf_)                                                         \
  {                                                                                             \
    float bb_[8];                                                                               \
    if (islat_) {                                                                               \
      const float* rp_ = rpb + (rs + (st_) - r + 7) * 31;                                       \
      _Pragma("unroll") for (int e = 0; e < 8; ++e) bb_[e] = rp_[bcol[e]];                      \
    }                                                                                           \
    const char* kt_ = smem + (buf_) * 16384;                                                    \
    const char* vt_ = kt_ + 8192;                                                               \
    const int r0_ = (cb_) + koff0, r1_ = (cb_) + koff1;                                         \
    const bf16x8 k00 = *(const bf16x8*)(kt_ + r0_ * 128 + (((lq) ^ (r0_ & 7)) << 4));           \
    const bf16x8 k01 = *(const bf16x8*)(kt_ + r0_ * 128 + (((4 + lq) ^ (r0_ & 7)) << 4));       \
    const bf16x8 k10 = *(const bf16x8*)(kt_ + r1_ * 128 + (((lq) ^ (r1_ & 7)) << 4));           \
    const bf16x8 k11 = *(const bf16x8*)(kt_ + r1_ * 128 + (((4 + lq) ^ (r1_ & 7)) << 4));       \
    const int vch_ = ((cb_) >> 3) + lq;                                                         \
    bf16x8 vf_[4];                                                                              \
    _Pragma("unroll") for (int dt = 0; dt < 4; ++dt) {                                          \
      const int d_ = dt * 16 + lr;                                                              \
      vf_[dt] = *(const bf16x8*)(vt_ + d_ * 128 + (((vch_) ^ (d_ & 7)) << 4));                  \
    }                                                                                           \
    f32x4 s0 = f32x4{0.f, 0.f, 0.f, 0.f}, s1 = s0;                                              \
    s0 = __builtin_amdgcn_mfma_f32_16x16x32_bf16(k00, qf[0], s0, 0, 0, 0);                      \
    s1 = __builtin_amdgcn_mfma_f32_16x16x32_bf16(k10, qf[0], s1, 0, 0, 0);                      \
    s0 = __builtin_amdgcn_mfma_f32_16x16x32_bf16(k01, qf[1], s0, 0, 0, 0);                      \
    s1 = __builtin_amdgcn_mfma_f32_16x16x32_bf16(k11, qf[1], s1, 0, 0, 0);                      \
    float v[8];                                                                                 \
    _Pragma("unroll") for (int e = 0; e < 4; ++e) { v[e] = s0[e] * sc; v[4 + e] = s1[e] * sc; } \
    if (islat_) {                                                                               \
      _Pragma("unroll") for (int e = 0; e < 8; ++e) v[e] = bval[e] ? v[e] + bb_[e] * LOG2E : -INFINITY; \
    }                                                                                           \
    float mx = v[0];                                                                            \
    _Pragma("unroll") for (int e = 1; e < 8; ++e) mx = fmaxf(mx, v[e]);                         \
    mx = max_x16(mx);                                                                           \
    mx = max_x32(mx);                                                                           \
    const float mnew = fmaxf(m, mx);                                                            \
    const float corr = __builtin_amdgcn_exp2f(m - mnew);                                                         \
    m = mnew;                                                                                   \
    float ps = 0.f;                                                                             \
    _Pragma("unroll") for (int e = 0; e < 8; ++e) { v[e] = __builtin_amdgcn_exp2f(v[e] - mnew); ps += v[e]; }    \
    lsum = lsum * corr + ps;                                                                    \
    const uint4 pu = make_uint4(pack2(v[0], v[1]), pack2(v[2], v[3]), pack2(v[4], v[5]), pack2(v[6], v[7])); \
    const bf16x8 pf = __builtin_bit_cast(bf16x8, pu);                                           \
    _Pragma("unroll") for (int dt = 0; dt < 4; ++dt) {                                          \
      O[dt][0] *= corr; O[dt][1] *= corr; O[dt][2] *= corr; O[dt][3] *= corr;                   \
      O[dt] = __builtin_amdgcn_mfma_f32_16x16x32_bf16(vf_[dt], pf, O[dt], 0, 0, 0);             \
    }                                                                                           \
  }
#define AT_STAGE(st_)                                                                           \
  if ((st_) < 8) {                                                                              \
    AT_PAIR(true, st_, kc0, (st_) & 1)                                                          \
  } else {                                                                                      \
    AT_PAIR(false, st_, 0, (st_) & 1)                                                           \
    AT_PAIR(false, st_, 32, (st_) & 1)                                                          \
  }
  lds_barrier();
  AT_LOAD(0, A)
  AT_LOAD(1, B)
  AT_LOAD(2, C)
  AT_STORE(0, A)
  lds_barrier();
#pragma unroll 1
  for (int st = 0; st < 12; st += 3) {
    if (st + 3 < 12) { AT_LOAD(st + 3, A) }
    AT_STAGE(st)
    AT_STORE((st + 1) & 1, B)
    lds_barrier();
    if (st + 4 < 12) { AT_LOAD(st + 4, B) }
    AT_STAGE(st + 1)
    AT_STORE((st + 2) & 1, C)
    lds_barrier();
    if (st + 5 < 12) { AT_LOAD(st + 5, C) }
    AT_STAGE(st + 2)
    if (st + 3 < 12) { AT_STORE((st + 3) & 1, A) }
    lds_barrier();
  }
#undef AT_STAGE
#undef AT_LOAD
#undef AT_STORE
#undef AT_PAIR
  lsum = sum_x16(lsum);
  lsum = sum_x32(lsum);
  const float inv = __builtin_amdgcn_rcpf(lsum);
#pragma unroll
  for (int dt = 0; dt < 4; ++dt) {
    uint2 o;
    o.x = pack2(O[dt][0] * inv, O[dt][1] * inv);
    o.y = pack2(O[dt][2] * inv, O[dt][3] * inv);
    *(uint2*)(Qb + qtok * 512 + h * 64 + dt * 16 + lq * 4) = o;
  }
}

PHASE_FN void phase_mixer(const Params& p, char* smem, int bid, int nblk) {
  for (int it = bid; it < 128; it += nblk) ssd_mfma_item(p, it * 2 + vhalf(), smem);
  unsigned* qcnt = (unsigned*)(p.ws + OFF_CNT) + 16;
  int* sh = (int*)(smem + 110592);
  for (;;) {
    lds_barrier();
    if (ltid() == 0) *sh = (int)atomicAdd(qcnt, 1u);
    lds_barrier();
    const int bu2 = *sh;
    if (bu2 >= NB * 8 * 64 / 2) break;
    attn_mfma_unit(p, bu2 * 2 + vhalf(), smem);
  }
}

PHASE_FN void phase_gated(const Params& p, char* smem, int bid, int nblk) {
  const int lane = ltid() & 63, gw = bid * 8 + (ltid() >> 6), nw = nblk * 8;
  u16* Y0 = (u16*)(p.ws + OFF_Y0);
  const u16* Y1 = (const u16*)(p.ws + OFF_Y1);
  const u16* Zb = (const u16*)(p.ws + OFF_ZB);
  const u16* Xs = (const u16*)(p.ws + OFF_XBC);
  for (int row = gw; row < NTOK; row += nw) {
    float yz[16], gs[2];
#pragma unroll
    for (int s = 0; s < 2; ++s) {
      const int c = lane * 8 + 512 * s;
      const int hh = c >> 6;
      const float dsk = p.ssm_d[hh] + p.ssm_d[16 + hh];
      float a[8], bq[8], z[8], xs[8];
      unpack8(*(const uint4*)(Y0 + (size_t)row * D + c), a);
      unpack8(*(const uint4*)(Y1 + (size_t)row * D + c), bq);
      unpack8(*(const uint4*)(Zb + (size_t)row * D + c), z);
      unpack8(*(const uint4*)(Xs + (size_t)row * XBCW + c), xs);
      float q = 0.f;
#pragma unroll
      for (int k = 0; k < 8; ++k) {
        const float y = a[k] + bq[k] + dsk * xs[k];
        yz[s * 8 + k] = y * silu_f(z[k]);
        q += yz[s * 8 + k] * yz[s * 8 + k];
      }
      q = sum_x16(q);
#pragma unroll
      for (int o = 8; o > 0; o >>= 1) q += __shfl_xor(q, o);
      gs[s] = q;
    }
#pragma unroll
    for (int s = 0; s < 2; ++s) {
      const int c = lane * 8 + 512 * s;
      const float rstd = rsqrtf(gs[s] * (1.f / 256.f) + 1e-6f);
      float g[8], o[8];
      ld8f(p.ssm_norm_g + c, g);
#pragma unroll
      for (int k = 0; k < 8; ++k) o[k] = yz[s * 8 + k] * rstd * g[k];
      *(uint4*)(Y0 + (size_t)row * D + c) = pack8(o);
    }
  }
}

constexpr int FFN_NUP = 16 * 88, FFN_NDN = 44 * 16;
constexpr int FFN_CONV_FIRST = FFN_NUP / 2, FFN_CONV_TOTAL = FFN_NUP + FFN_NDN;
DEV void ffn_convert_pair(const Params& p, int id2, char* smem) {
  const int id = id2 * 2 + vhalf();
  const int l = id / (FFN_NUP + FFN_NDN), r = id % (FFN_NUP + FFN_NDN);
  if (r < FFN_NUP) {
    const int nt = r % 88;
    convert_tile(p.w_up + (size_t)l * D * FFH2, D, FFH2, (u16*)(p.ws + OFF_WUP + l * WUP_SZ), r / 88, nt, smem,
                 nt < 44 ? (nt >> 1) * 256 + (nt & 1) * 64 : ((nt - 44) >> 1) * 256 + 128 + ((nt - 44) & 1) * 64);
  } else convert_tile(p.w_down + (size_t)l * FFH * D, FFH, D, (u16*)(p.ws + OFF_WDOWN + l * WDOWN_SZ), (r - FFN_NUP) / 16, (r - FFN_NUP) % 16, smem);
}

struct EpiY {
  u16* ybuf; float* ssqb; int c0; int t0; int it; const float* bias; const float* scale;
  DEV f32x4 store(int i, int j, f32x4 v) {
    const int c = c0 + i, t = t0 + j;
    if (bias) {
      const float4 bb = *(const float4*)(bias + c), sc = *(const float4*)(scale + c);
      v[0] = (v[0] + bb.x) * sc.x; v[1] = (v[1] + bb.y) * sc.y; v[2] = (v[2] + bb.z) * sc.z; v[3] = (v[3] + bb.w) * sc.w;
    }
    uint2 o; o.x = pack2(v[0], v[1]); o.y = pack2(v[2], v[3]);
    *(uint2*)(ybuf + (size_t)t * D + c) = o;
    return v;
  }
  DEV void ssq(int j, int wi, float s) { ssqb[(size_t)(t0 + j) * 8 + it * 2 + wi] = s; }
  DEV bool wide() const { return true; }
  DEV f32x4 xform(int i, int, f32x4 v) const {
    if (bias) {
      const int c = c0 + i;
      const float4 bb = *(const float4*)(bias + c), sc = *(const float4*)(scale + c);
      v[0] = (v[0] + bb.x) * sc.x; v[1] = (v[1] + bb.y) * sc.y; v[2] = (v[2] + bb.z) * sc.z; v[3] = (v[3] + bb.w) * sc.w;
    }
    return v;
  }
  DEV void store8(int i8, int j, uint4 o) { nt_store16(ybuf + (size_t)(t0 + j) * D + c0 + i8, o); }
};

PHASE_FN void phase_outproj(const Params& p, char* smem, int bid, int nblk) {
  for (int id2 = bid; id2 < FFN_CONV_FIRST; id2 += nblk) ffn_convert_pair(p, id2, smem);
  constexpr int NI = 4, NJ = NTOK / 256;
  const u16* WT = (const u16*)(p.ws + OFF_WOUT);
  TileIter ti(bid, nblk, NI, NJ);
  int it, jt;
  while (ti.next(it, jt)) {
    if (it < 0) continue;
    SrcPlain ps{WT + (size_t)it * 256 * MIXW, MIXW};
    SrcCat qs{(const u16*)(p.ws + OFF_QB) + (size_t)jt * 256 * 512, 512, 512, (const u16*)(p.ws + OFF_Y0) + (size_t)jt * 256 * D, D};
    EpiY epi{(u16*)(p.ws + OFF_YBUF), (float*)(p.ws + OFF_SSQ), it * 256, jt * 256, it, nullptr, nullptr};
    gemm_tile<true>(ps, qs, MIXW, smem, epi);
  }
}

PHASE_FN void phase_poolgemm(const Params& p, char* smem, int bid, int nblk) {
  constexpr int NI = 4, NJ = NTOK / 256;
  const u16* WT = (const u16*)(p.ws + OFF_POOLT);
  for (int id = bid; id < NI * NJ; id += nblk) {
    const int it = id % NI, jt = id / NI;
    SrcPlain ps{WT + (size_t)it * 65536, 256};
    SrcPlain qs{(const u16*)(p.ws + OFF_POOLED) + (size_t)jt * 256 * D + it * 256, D};
    EpiY epi{(u16*)(p.ws + OFF_YBUF), (float*)(p.ws + OFF_SSQ), it * 256, jt * 256, it, p.pool_b, p.pool_scale};
    gemm_tile<true>(ps, qs, 256, smem, epi);
  }
}

PHASE_FN void phase_up(const Params& p, char* smem, int bid, int nblk, int l) {
  constexpr int NI = FFH / 128, NJ = (NTOK + 253) / 254;
  const u16* WT = (const u16*)(p.ws + OFF_WUP + l * WUP_SZ);
  u16* gact = (u16*)(p.ws + OFF_UV);
  const float* cw = p.fconv_w + (size_t)l * 3 * FFH;
  const float* cb = p.fconv_b + (size_t)l * FFH;
  TileIter ti(bid, nblk, NI, NJ);
  int it, jt;
  while (ti.next(it, jt)) {
    if (it < 0) continue;
    const int t0 = jt * 254 - 1;
    SrcPlain ps{WT + (size_t)it * 256 * D, D};
    SrcHalo qs{(const u16*)(p.ws + OFF_HA), D, t0, NTOK - 1};
    f32x4 acc[8][4];
    gemm_mainloop(ps, qs, D, smem, acc);
    const int tid = ltid(), lane = tid & 63, wave = tid >> 6;
    const int wi = wave >> 2, wj = wave & 3, lr = lane & 15, lq = lane >> 4;
    char* dst = smem + wi * 69632;
#pragma unroll
    for (int n = 0; n < 4; ++n) {
      const int jj = wj * 64 + n * 16 + lr;
#pragma unroll
      for (int m = 0; m < 8; ++m) {
        const int c = m * 16 + lq * 4;
        uint2 o; o.x = pack2(acc[m][n][0], acc[m][n][1]); o.y = pack2(acc[m][n][2], acc[m][n][3]);
        *(uint2*)(dst + jj * 272 + c * 2) = o;
      }
    }
    lds_barrier();
    {
      const int c8 = (tid & 15) * 8;
      const int cg = it * 128 + c8;
      f32x2v w0[4], w1[4], w2[4], bv[4];
#pragma unroll
      for (int q = 0; q < 4; ++q) {
        w0[q] = f32x2v{cw[cg + 2 * q], cw[cg + 2 * q + 1]};
        w1[q] = f32x2v{cw[FFH + cg + 2 * q], cw[FFH + cg + 2 * q + 1]};
        w2[q] = f32x2v{cw[2 * FFH + cg + 2 * q], cw[2 * FFH + cg + 2 * q + 1]};
        bv[q] = f32x2v{cb[cg + 2 * q], cb[cg + 2 * q + 1]};
      }
#pragma unroll 2
      for (int i = 0; i < 8; ++i) {
        const int jj = (tid >> 4) + 32 * i;
        const int t = t0 + jj;
        if (jj >= 1 && jj <= 254 && t < NTOK) {
          uint4 um = *(const uint4*)(smem + (jj - 1) * 272 + c8 * 2);
          const uint4 uc = *(const uint4*)(smem + jj * 272 + c8 * 2);
          uint4 up = *(const uint4*)(smem + (jj + 1) * 272 + c8 * 2);
          const uint4 vv = *(const uint4*)(smem + 69632 + jj * 272 + c8 * 2);
          if ((t & (SEQ - 1)) == 0) um = make_uint4(0u, 0u, 0u, 0u);
          if ((t & (SEQ - 1)) == SEQ - 1) up = make_uint4(0u, 0u, 0u, 0u);
          const unsigned umv[4] = {um.x, um.y, um.z, um.w}, ucv[4] = {uc.x, uc.y, uc.z, uc.w};
          const unsigned upv[4] = {up.x, up.y, up.z, up.w}, vvv[4] = {vv.x, vv.y, vv.z, vv.w};
          unsigned ov[4];
#pragma unroll
          for (int q = 0; q < 4; ++q) {
            const f32x2v u = w0[q] * bfpair(umv[q]) + w1[q] * bfpair(ucv[q]) + w2[q] * bfpair(upv[q]) + bv[q];
            const f32x2v g = gelu2(u) * bfpair(vvv[q]);
            ov[q] = pack2(g.x, g.y);
          }
          nt_store16(gact + (size_t)t * FFH + cg, make_uint4(ov[0], ov[1], ov[2], ov[3]));
        }
      }
    }
  }
  if (l == 0) {
    unsigned* qc = (unsigned*)(p.ws + OFF_CNT) + 17;
    int* sh = (int*)(smem + 140000);
    for (;;) {
      __syncthreads();
      if (ltid() == 0) *sh = (int)atomicAdd(qc, 1u);
      __syncthreads();
      const int id2 = FFN_CONV_FIRST + *sh;
      if (id2 >= FFN_CONV_TOTAL) break;
      ffn_convert_pair(p, id2, smem);
    }
  }
}

PHASE_FN void phase_down(const Params& p, char* smem, int bid, int nblk, int l) {
  constexpr int NI = 4, NJ = NTOK / 256;
  const u16* WT = (const u16*)(p.ws + OFF_WDOWN + l * WDOWN_SZ);
  TileIter ti(bid, nblk, NI, NJ);
  int it, jt;
  while (ti.next(it, jt)) {
    if (it < 0) continue;
    SrcPlain ps{WT + (size_t)it * 256 * FFH, FFH};
    SrcPlain qs{(const u16*)(p.ws + OFF_UV) + (size_t)jt * 256 * FFH, FFH};
    EpiY epi{(u16*)(p.ws + OFF_YBUF), (float*)(p.ws + OFF_SSQ), it * 256, jt * 256, it, nullptr, nullptr};
    gemm_tile<true>(ps, qs, FFH, smem, epi);
  }
}

template <int W>
DEV void pool_task(const u16* h1, u16* pooled, int token, int c8) {
  const int b = token / SEQ, t = token % SEQ;
  const int lo = t - W / 2;
  const u16* base = h1 + (size_t)b * SEQ * D + c8;
  uint4 raw[W];
#pragma unroll
  for (int j = 0; j < W; ++j) {
    const int tt = min(max(lo + j, 0), SEQ - 1);
    raw[j] = *(const uint4*)(base + (size_t)tt * D);
  }
  float s[8];
#pragma unroll
  for (int e = 0; e < 8; ++e) s[e] = 0.f;
  float self[8];
#pragma unroll
  for (int j = 0; j < W; ++j) {
    float v[8];
    unpack8(raw[j], v);
    const bool ok = (unsigned)(lo + j) < (unsigned)SEQ;
#pragma unroll
    for (int e = 0; e < 8; ++e) s[e] += ok ? v[e] : 0.f;
    if (j == W / 2) {
#pragma unroll
      for (int e = 0; e < 8; ++e) self[e] = v[e];
    }
  }
  const int cnt = min(lo + W, SEQ) - max(lo, 0);
  const float inv = __builtin_amdgcn_rcpf((float)cnt);
  float o[8];
#pragma unroll
  for (int e = 0; e < 8; ++e) o[e] = s[e] * inv - self[e];
  *(uint4*)(pooled + (size_t)token * D + c8) = pack8(o);
}

PHASE_FN void phase_pool(const Params& p, int bid, int nblk) {
  const u16* h1 = (const u16*)(p.ws + OFF_HA);
  u16* pooled = (u16*)(p.ws + OFF_POOLED);
  const int lane = ltid() & 63, gw = bid * 8 + (ltid() >> 6), nw = nblk * 8;
  for (int wt = gw; wt < (NTOK / 2) * 4; wt += nw) {
    const int g = wt & 3, tp = wt >> 2;
    const int token = tp * 2 + (lane >> 5);
    const int c8 = (g * 32 + (lane & 31)) * 8;
    if (g == 0) pool_task<2>(h1, pooled, token, c8);
    else if (g == 1) pool_task<4>(h1, pooled, token, c8);
    else if (g == 2) pool_task<8>(h1, pooled, token, c8);
    else pool_task<16>(h1, pooled, token, c8);
  }
}

#if MK_COOP
DEV void grid_barrier(unsigned* cnt, unsigned& target, unsigned nblk) {
  asm volatile("s_waitcnt vmcnt(0)" ::: "memory");
  __syncthreads();
  target += 1;
  if (ltid() == 0) {
    __builtin_amdgcn_fence(__ATOMIC_RELEASE, "agent");
    asm volatile("s_waitcnt vmcnt(0)" ::: "memory");
    const unsigned shard = blockIdx.x & 7u;
    const unsigned per = nblk >> 3;
    const unsigned old = __hip_atomic_fetch_add(cnt + 320 + 64 * shard, 1u, __ATOMIC_RELAXED, __HIP_MEMORY_SCOPE_AGENT);
    if (old + 1u == target * per) __hip_atomic_fetch_add(cnt + 256, 1u, __ATOMIC_RELAXED, __HIP_MEMORY_SCOPE_AGENT);
    while (__hip_atomic_load(cnt + 256, __ATOMIC_RELAXED, __HIP_MEMORY_SCOPE_AGENT) < target * 8u) __builtin_amdgcn_s_sleep(1);
    __builtin_amdgcn_fence(__ATOMIC_ACQUIRE, "agent");
    asm volatile("s_waitcnt vmcnt(0)" ::: "memory");
  }
  __syncthreads();
}

typedef const __attribute__((address_space(4))) Params* KParamPtr;
DEV Params load_params() {
  KParamPtr kp = (KParamPtr)__builtin_amdgcn_kernarg_segment_ptr();
  asm volatile("" : "+s"(kp));
#if defined(__HIP_DEVICE_COMPILE__)
  return *kp;
#else
  return Params{};
#endif
}
#define PH(call) { const Params p = load_params(); call; }
__global__ void __launch_bounds__(512, 2) mega_kernel(Params p_in) {
  __shared__ __attribute__((aligned(16))) char smem[SMEM_BYTES];
  const int bid = blockIdx.x, nblk = gridDim.x;
  if (p_in.ws == nullptr) cg::this_grid().sync();
  unsigned target = 0;
#define GSYNC() { unsigned* cnt_; { const Params p = load_params(); cnt_ = (unsigned*)(p.ws + OFF_CNT); } grid_barrier(cnt_, target, (unsigned)nblk); }
  PH(phase0(p, smem, bid, nblk)); GSYNC();
  PH(phase_norm_in(p, bid, nblk)); GSYNC();
  PH(phase_inproj(p, smem, bid, nblk)); GSYNC();
  PH(phase_conv(p, smem, bid, nblk)); GSYNC();
  PH(phase_mixer(p, smem, bid, nblk)); GSYNC();
  PH(phase_gated(p, smem, bid, nblk)); GSYNC();
  PH(phase_outproj(p, smem, bid, nblk)); GSYNC();
  for (int l = 0; l < 2; ++l) {
    if (l == 1) {
      PH(phase_pool(p, bid, nblk)); GSYNC();
      PH(phase_poolgemm(p, smem, bid, nblk)); GSYNC();
    }
    {
      const Params p = load_params();
      const float* ml = (const float*)(p.ws + OFF_MOD) + (size_t)l * 9 * 6144;
      const float* ng = p.norm_g + (size_t)l * 4096;
      u16* res = (u16*)(p.ws + OFF_RES);
      if (l == 0) phase_row_update<false, true>(p, bid, nblk, p.x, res, ml + 2048, ng + 1024, true, ng + 2048, ml + 3072, ml + 4096);
      else phase_row_update<true, true>(p, bid, nblk, res, res, ml + 2048, ng + 1024, true, ng + 2048, ml + 3072, ml + 4096);
    }
    GSYNC();
    PH(phase_up(p, smem, bid, nblk, l)); GSYNC();
    PH(phase_down(p, smem, bid, nblk, l)); GSYNC();
    {
      const Params p = load_params();
      const float* mod = (const float*)(p.ws + OFF_MOD);
      const float* ml = mod + (size_t)l * 9 * 6144;
      const float* ng = p.norm_g + (size_t)l * 4096;
      u16* res = (u16*)(p.ws + OFF_RES);
      if (l == 0) phase_row_update<true, true>(p, bid, nblk, res, res, ml + 5120, ng + 3072, true, p.norm_g + 4096, mod + 9 * 6144, mod + 9 * 6144 + 1024);
      else phase_row_update<true, false>(p, bid, nblk, res, p.out, ml + 5120, ng + 3072, false, p.norm_g + 4096, mod + 9 * 6144, mod + 9 * 6144 + 1024);
    }
    if (l == 0) GSYNC();
  }
}
#endif

extern "C" void kernel_launch(void* const* d_in, const int* in_sizes, int n_in, void* d_out, int out_size, void* d_ws,
                              size_t ws_size, hipStream_t stream) {
  Params p{};
  const float** f = (const float**)&p;
  for (int i = 0; i < 23; ++i) f[i] = (const float*)d_in[i];
  p.out = (float*)d_out;
  p.ws = (char*)d_ws;
#if MK_COOP
  static int grid_blocks = 0;
  if (!grid_blocks) {
    int dev = 0, cus = 0, per_cu = 0;
    hipGetDevice(&dev);
    hipDeviceGetAttribute(&cus, hipDeviceAttributeMultiprocessorCount, dev);
    hipOccupancyMaxActiveBlocksPerMultiprocessor(&per_cu, mega_kernel, 512, 0);
    if (per_cu > 1) per_cu = 1;
    grid_blocks = cus * per_cu;
  }
  hipMemsetAsync(p.ws + OFF_CNT, 0, 4096, stream);
  void* args[] = {&p};
  hipError_t e = hipLaunchCooperativeKernel((void*)mega_kernel, dim3(grid_blocks), dim3(512), args, 0, stream);
  if (e != hipSuccess) fprintf(stderr, "cooperative launch failed: %s (grid %d)\n", hipGetErrorString(e), grid_blocks);
#endif
}
```

```cpp
#include <hip/hip_runtime.h>
#include <hip/hip_cooperative_groups.h>
#include <cstdio>
namespace cg = cooperative_groups;

#ifndef MK_COOP
#define MK_COOP 1
#endif

#define DEV __device__ __forceinline__
#define PHASE_FN __device__ __forceinline__
typedef unsigned short u16;
typedef __attribute__((ext_vector_type(8))) short bf16x8;
typedef __attribute__((ext_vector_type(4))) float f32x4;

constexpr int D = 1024, NB = 8, SEQ = 4096, NTOK = NB * SEQ, CTXL = 256, NCTX = NB * CTXL;
constexpr int INW = 4640, INWP = 4864, MIXW = 1536, FFH = 2816, FFH2 = 5632;
constexpr int XBCW = 2048;
constexpr size_t MiB = 1u << 20;
constexpr size_t OFF_WIN = 0, OFF_WOUT = 10 * MiB, OFF_POOLT = 13 * MiB, OFF_MOD = 14 * MiB,
                 OFF_DTRAW = 15 * MiB, OFF_DTRAWC = 19 * MiB, OFF_SSQ = 20 * MiB, OFF_CNT = 22 * MiB,
                 OFF_KC = 24 * MiB, OFF_VC = 26 * MiB, OFF_XBCC = 28 * MiB, OFF_HA = 36 * MiB,
                 OFF_Y1 = OFF_HA, OFF_HC = 100 * MiB, OFF_QB = 104 * MiB, OFF_Y0 = 136 * MiB,
                 OFF_ZB = 200 * MiB, OFF_YBUF = 264 * MiB, OFF_KB = 264 * MiB, OFF_VB = 296 * MiB, OFF_RES = 100 * MiB,
                 OFF_WUP = 228 * MiB, OFF_WDOWN = 250 * MiB, OFF_XBC = 328 * MiB, OFF_VT = 456 * MiB,
                 OFF_HALO = 488 * MiB, OFF_VCT = 494 * MiB, OFF_UV = 328 * MiB, OFF_GACT = 104 * MiB, OFF_POOLED = 328 * MiB;
constexpr size_t WUP_SZ = (size_t)FFH2 * D * 2, WDOWN_SZ = (size_t)D * FFH * 2;

struct Params {
  const float *x, *c, *ctx, *c_ctx, *ada_w, *ada_b, *norm_g, *w_in, *w_out, *na_rpb, *conv_w, *conv_b,
      *a_log, *dt_bias, *ssm_d, *ssm_norm_g, *pool_w, *pool_b, *pool_scale, *w_up, *fconv_w, *fconv_b, *w_down;
  float* out;
  char* ws;
};

DEV int ltid() { int t = (int)__builtin_amdgcn_workitem_id_x(); asm volatile("" : "+v"(t)); return t; }
DEV int vtid() { return ltid() & 255; }
DEV int vhalf() { return ltid() >> 8; }
constexpr int SMEM_BYTES = 143360;
DEV void lds_barrier() {
  asm volatile("s_waitcnt lgkmcnt(0)" ::: "memory");
  __builtin_amdgcn_s_barrier();
  asm volatile("" ::: "memory");
}
typedef unsigned u32x4v __attribute__((ext_vector_type(4)));
DEV void nt_store16(void* p, uint4 v) {
  const u32x4v t = {v.x, v.y, v.z, v.w};
  __builtin_nontemporal_store(t, (u32x4v*)p);
}
typedef unsigned u32x2s __attribute__((ext_vector_type(2)));
DEV float max_x16(float x) { const u32x2s r = __builtin_amdgcn_permlane16_swap(__float_as_uint(x), __float_as_uint(x), false, false); return fmaxf(__uint_as_float(r[0]), __uint_as_float(r[1])); }
DEV float max_x32(float x) { const u32x2s r = __builtin_amdgcn_permlane32_swap(__float_as_uint(x), __float_as_uint(x), false, false); return fmaxf(__uint_as_float(r[0]), __uint_as_float(r[1])); }
DEV float sum_x16(float x) { const u32x2s r = __builtin_amdgcn_permlane16_swap(__float_as_uint(x), __float_as_uint(x), false, false); return __uint_as_float(r[0]) + __uint_as_float(r[1]); }
DEV float sum_x32(float x) { const u32x2s r = __builtin_amdgcn_permlane32_swap(__float_as_uint(x), __float_as_uint(x), false, false); return __uint_as_float(r[0]) + __uint_as_float(r[1]); }
DEV u16 f2bf(float f) {
  unsigned u = __float_as_uint(f);
  u += 0x7fffu + ((u >> 16) & 1u);
  return (u16)(u >> 16);
}
DEV float bf2f(u16 h) { return __uint_as_float(((unsigned)h) << 16); }
typedef __attribute__((ext_vector_type(2))) __bf16 bf16x2_t;
typedef __attribute__((ext_vector_type(2))) float f32x2_t;
DEV unsigned pack2(float a, float b) {
  f32x2_t v = {a, b};
  return __builtin_bit_cast(unsigned, __builtin_convertvector(v, bf16x2_t));
}
typedef __attribute__((ext_vector_type(4))) short s16x4;
DEV s16x4 lds_tr(const char* p) { return __builtin_amdgcn_ds_read_tr16_b64_v4i16((__attribute__((address_space(3))) s16x4*)p); }
DEV bf16x8 cat4(s16x4 a, s16x4 b) { return bf16x8{a[0], a[1], a[2], a[3], b[0], b[1], b[2], b[3]}; }
DEV float lo2f(unsigned u) { return __uint_as_float(u << 16); }
DEV float hi2f(unsigned u) { return __uint_as_float(u & 0xffff0000u); }
DEV float wave_sum(float v) {
#pragma unroll
  for (int o = 32; o > 0; o >>= 1) v += __shfl_xor(v, o);
  return v;
}
DEV float wave_max(float v) {
#pragma unroll
  for (int o = 32; o > 0; o >>= 1) v = fmaxf(v, __shfl_xor(v, o));
  return v;
}
DEV float silu_f(float v) { return v * __builtin_amdgcn_rcpf(1.f + __expf(-v)); }
DEV float erf_f(float x) {
  const float ax = fabsf(x);
  const float t = __builtin_amdgcn_rcpf(1.f + 0.3275911f * ax);
  float poly = 1.061405429f;
  poly = poly * t - 1.453152027f;
  poly = poly * t + 1.421413741f;
  poly = poly * t - 0.284496736f;
  poly = poly * t + 0.254829592f;
  poly *= t;
  const float r = 1.f - poly * __builtin_amdgcn_exp2f(-1.44269504089f * ax * ax);
  return copysignf(r, x);
}
typedef float f32x2v __attribute__((ext_vector_type(2)));
DEV f32x2v gelu2(f32x2v u) {
  const f32x2v z = u * 0.70710678118f;
  const f32x2v az = {fabsf(z.x), fabsf(z.y)};
  const f32x2v den = az * 0.3275911f + 1.f;
  const f32x2v t = {__builtin_amdgcn_rcpf(den.x), __builtin_amdgcn_rcpf(den.y)};
  f32x2v poly = t * 1.061405429f - 1.453152027f;
  poly = poly * t + 1.421413741f;
  poly = poly * t - 0.284496736f;
  poly = poly * t + 0.254829592f;
  poly = poly * t;
  const f32x2v ex = az * az * (-1.44269504089f);
  const f32x2v e = {__builtin_amdgcn_exp2f(ex.x), __builtin_amdgcn_exp2f(ex.y)};
  const f32x2v r = 1.f - poly * e;
  const f32x2v er = {copysignf(r.x, z.x), copysignf(r.y, z.y)};
  return (u * 0.5f) * (er + 1.f);
}
DEV f32x2v bfpair(unsigned u) { return f32x2v{lo2f(u), hi2f(u)}; }
DEV float gelu_f(float u) { return 0.5f * u * (1.f + erf_f(u * 0.70710678118f)); }
DEV float softplus_f(float v) {
  const float e = __expf(v);
  const float small = e * (1.f - e * (0.5f - e * (1.f / 3.f)));
  return v > 20.f ? v : (e < 0.01f ? small : __logf(1.f + e));
}
DEV void unpack8(const uint4& u, float* f) {
  f[0] = lo2f(u.x); f[1] = hi2f(u.x); f[2] = lo2f(u.y); f[3] = hi2f(u.y);
  f[4] = lo2f(u.z); f[5] = hi2f(u.z); f[6] = lo2f(u.w); f[7] = hi2f(u.w);
}
DEV uint4 pack8(const float* f) {
  uint4 u;
  u.x = pack2(f[0], f[1]); u.y = pack2(f[2], f[3]); u.z = pack2(f[4], f[5]); u.w = pack2(f[6], f[7]);
  return u;
}

struct SrcPlain {
  const u16* base; int ld;
  DEV const char* kbase(int kt) const { return (const char*)(base + kt * 64); }
  DEV unsigned ldbytes(int) const { return (unsigned)ld * 2u; }
  DEV unsigned rowidx(unsigned r) const { return r; }
  DEV uint4 mask(uint4 v, unsigned) const { return v; }
};
struct SrcHalo {
  const u16* base; int ld; int t0; int tmax;
  DEV const char* kbase(int kt) const { return (const char*)(base + kt * 64); }
  DEV unsigned ldbytes(int) const { return (unsigned)ld * 2u; }
  DEV unsigned rowidx(unsigned r) const { return (unsigned)min(max(t0 + (int)r, 0), tmax); }
  DEV uint4 mask(uint4 v, unsigned r) const { return ((unsigned)(t0 + (int)r) < (unsigned)SEQ) ? v : make_uint4(0, 0, 0, 0); }
};
struct SrcCat {
  const u16* a; int lda; int ka; const u16* b; int ldb;
  DEV const char* kbase(int kt) const { return kt * 64 < ka ? (const char*)(a + kt * 64) : (const char*)(b + (kt * 64 - ka)); }
  DEV unsigned ldbytes(int kt) const { return (unsigned)(kt * 64 < ka ? lda : ldb) * 2u; }
  DEV unsigned rowidx(unsigned r) const { return r; }
  DEV uint4 mask(uint4 v, unsigned) const { return v; }
};

DEV void gemm_compute(const char* pb, int wi, int wj, int lr, int lq, f32x4 (&acc)[8][4]) {
  const char* qb = pb + 32768;
#define FR_A(dst, ks_, mh_)                                                                      \
  _Pragma("unroll") for (int m = 0; m < 4; ++m) {                                                \
    const int row = wi * 128 + ((mh_) * 4 + m) * 16 + lr;                                        \
    dst[m] = *(const bf16x8*)(pb + row * 128 + ((((ks_) * 4 + lq) ^ (row & 7)) << 4));           \
  }
#define FR_B(dst, ks_)                                                                           \
  _Pragma("unroll") for (int n = 0; n < 4; ++n) {                                                \
    const int row = wj * 64 + n * 16 + lr;                                                       \
    dst[n] = *(const bf16x8*)(qb + row * 128 + ((((ks_) * 4 + lq) ^ (row & 7)) << 4));           \
  }
#define MM(A, B, mh_)                                                                            \
  _Pragma("unroll") for (int m = 0; m < 4; ++m)                                                  \
    _Pragma("unroll") for (int n = 0; n < 4; ++n)                                                \
      acc[(mh_) * 4 + m][n] = __builtin_amdgcn_mfma_f32_16x16x32_bf16(A[m], B[n], acc[(mh_) * 4 + m][n], 0, 0, 0);
  bf16x8 b0[4], b1[4], a0[4], a1[4];
  FR_B(b0, 0) FR_A(a0, 0, 0)
  FR_A(a1, 0, 1)
  __builtin_amdgcn_sched_barrier(0);
  MM(a0, b0, 0)
  __builtin_amdgcn_sched_barrier(0);
  FR_B(b1, 1) FR_A(a0, 1, 0)
  __builtin_amdgcn_sched_barrier(0);
  MM(a1, b0, 1)
  __builtin_amdgcn_sched_barrier(0);
  FR_A(a1, 1, 1)
  __builtin_amdgcn_sched_barrier(0);
  MM(a0, b1, 0)
  __builtin_amdgcn_sched_barrier(0);
  MM(a1, b1, 1)
#undef FR_A
#undef FR_B
#undef MM
}

typedef __attribute__((address_space(3))) unsigned lds_u32_t;
template <class PS, class QS>
DEV void gemm_mainloop(const PS& ps, const QS& qs, int K, char* smem, f32x4 (&acc)[8][4]) {
  const int tid = ltid(), lane = tid & 63, wave = tid >> 6;
  const int wi = wave >> 2, wj = wave & 3, lr = lane & 15, lq = lane >> 4;
#pragma unroll
  for (int m = 0; m < 8; ++m)
#pragma unroll
    for (int n = 0; n < 4; ++n) acc[m][n] = f32x4{0.f, 0.f, 0.f, 0.f};
  const int nk = K >> 6;
  const unsigned lrow = (unsigned)(lane >> 3);
  const unsigned gch = (unsigned)(((lane & 7) ^ (lane >> 3)) << 4);
  const int wbase = __builtin_amdgcn_readfirstlane(wave * 4);
#define G_DMA(kt_, buf_)                                                                        \
  {                                                                                             \
    const char* pbse_ = ps.kbase(kt_); const unsigned pld_ = ps.ldbytes(kt_);                   \
    const char* qbse_ = qs.kbase(kt_); const unsigned qld_ = qs.ldbytes(kt_);                   \
    _Pragma("unroll") for (int s_ = 0; s_ < 4; ++s_) {                                          \
      const unsigned row_ = (unsigned)(wbase + s_) * 8u + lrow;                                 \
      __builtin_amdgcn_global_load_lds((const unsigned*)(pbse_ + (ps.rowidx(row_) * pld_ + gch)), \
          (lds_u32_t*)(smem + (buf_) * 65536 + (wbase + s_) * 1024), 16, 0, 0);                 \
      __builtin_amdgcn_global_load_lds((const unsigned*)(qbse_ + (qs.rowidx(row_) * qld_ + gch)), \
          (lds_u32_t*)(smem + (buf_) * 65536 + 32768 + (wbase + s_) * 1024), 16, 0, 0);         \
    }                                                                                           \
  }
  lds_barrier();
  G_DMA(0, 0)
  asm volatile("s_waitcnt vmcnt(0)" ::: "memory");
  lds_barrier();
  for (int kt = 0; kt < nk; ++kt) {
    if (kt + 1 < nk) { G_DMA(kt + 1, (kt + 1) & 1) }
    gemm_compute(smem + (kt & 1) * 65536, wi, wj, lr, lq, acc);
    asm volatile("s_waitcnt vmcnt(0)" ::: "memory");
    lds_barrier();
  }
#undef G_DMA
}

typedef unsigned u32x2v __attribute__((ext_vector_type(2)));
template <bool SSQ, class PS, class QS, class Epi>
DEV void gemm_tile(const PS& ps, const QS& qs, int K, char* smem, Epi& epi) {
  f32x4 acc[8][4];
  gemm_mainloop(ps, qs, K, smem, acc);
  const int tid = ltid(), lane = tid & 63, wave = tid >> 6;
  const int wi = wave >> 2, wj = wave & 3, lr = lane & 15, lq = lane >> 4;
  if (epi.wide()) {
    const int isub = (lq & 1) ? 16 + (lq - 1) * 4 : lq * 4;
#pragma unroll
    for (int n = 0; n < 4; ++n) {
      const int j = wj * 64 + n * 16 + lr;
      float ss = 0.f;
#pragma unroll
      for (int mp = 0; mp < 4; ++mp) {
        const int ib = wi * 128 + mp * 32;
        const f32x4 va = epi.xform(ib + lq * 4, j, acc[2 * mp][n]);
        const f32x4 vb = epi.xform(ib + 16 + lq * 4, j, acc[2 * mp + 1][n]);
        if (SSQ) ss += va[0] * va[0] + va[1] * va[1] + va[2] * va[2] + va[3] * va[3] + vb[0] * vb[0] + vb[1] * vb[1] + vb[2] * vb[2] + vb[3] * vb[3];
        const unsigned ax = pack2(va[0], va[1]), ay = pack2(va[2], va[3]);
        const unsigned bx = pack2(vb[0], vb[1]), by = pack2(vb[2], vb[3]);
        const u32x2v rx = __builtin_amdgcn_permlane16_swap(ax, bx, false, false);
        const u32x2v ry = __builtin_amdgcn_permlane16_swap(ay, by, false, false);
        const uint4 o = (lq & 1) ? make_uint4(rx[0], ry[0], bx, by) : make_uint4(ax, ay, rx[1], ry[1]);
        epi.store8(ib + isub, j, o);
      }
      if (SSQ) {
        ss = sum_x16(ss);
        ss = sum_x32(ss);
        if (lq == 0) epi.ssq(j, wi, ss);
      }
    }
    return;
  }
#pragma unroll
  for (int n = 0; n < 4; ++n) {
    const int j = wj * 64 + n * 16 + lr;
    float ss = 0.f;
#pragma unroll
    for (int m = 0; m < 8; ++m) {
      const int i = wi * 128 + m * 16 + lq * 4;
      f32x4 v = epi.store(i, j, acc[m][n]);
      if (SSQ) ss += v[0] * v[0] + v[1] * v[1] + v[2] * v[2] + v[3] * v[3];
    }
    if (SSQ) {
      ss = sum_x16(ss);
      ss = sum_x32(ss);
      if (lq == 0) epi.ssq(j, wi, ss);
    }
  }
}

DEV void convert_tile(const float* W, int K, int N, u16* WT, int kt, int nt, char* smem, int drow0 = -1) {
  u16(*t)[72] = (u16(*)[72])(smem + vhalf() * 16384);
  const int tid = vtid();
  __syncthreads();
#pragma unroll
  for (int s = 0; s < 4; ++s) {
    const int k = (tid >> 4) + 16 * s, n4 = (tid & 15) * 4;
    const int gn = nt * 64 + n4;
    float4 v = make_float4(0.f, 0.f, 0.f, 0.f);
    if (gn < N) v = *(const float4*)(W + (size_t)(kt * 64 + k) * N + gn);
    t[n4 + 0][k] = f2bf(v.x); t[n4 + 1][k] = f2bf(v.y); t[n4 + 2][k] = f2bf(v.z); t[n4 + 3][k] = f2bf(v.w);
  }
  __syncthreads();
#pragma unroll
  for (int s = 0; s < 2; ++s) {
    const int n = (tid >> 3) + 32 * s, k8 = (tid & 7) * 8;
    const int gn = nt * 64 + n;
    const int drow = drow0 >= 0 ? drow0 + n : gn;
    if (gn < N) *(uint4*)(WT + (size_t)drow * K + kt * 64 + k8) = *(const uint4*)(&t[n][k8]);
  }
}

DEV void phase_ada_item(const Params& p, int item, char* smem) {
  const int l = item / 48, cc = item % 48, tid = vtid();
  smem += vhalf() * 40960;
  float* sc = (float*)smem;
  __syncthreads();
  for (int e = tid; e < 9 * 1024; e += 256) {
    const int r = e >> 10, k = e & 1023;
    const float v = r < 8 ? p.c[r * 1024 + k] : p.c_ctx[k];
    sc[e] = silu_f(v);
  }
  __syncthreads();
  const int kq = tid >> 5, l32 = tid & 31;
  const int n = cc * 128 + l32 * 4;
  float acc[9][4];
#pragma unroll
  for (int r = 0; r < 9; ++r)
#pragma unroll
    for (int q = 0; q < 4; ++q) acc[r][q] = 0.f;
  const float* W = p.ada_w + (size_t)l * 1024 * 6144 + n;
#pragma unroll 16
  for (int kk = 0; kk < 128; ++kk) {
    const int k = kq * 128 + kk;
    const float4 w = *(const float4*)(W + (size_t)k * 6144);
#pragma unroll
    for (int r = 0; r < 9; ++r) {
      const float s = sc[r * 1024 + k];
      acc[r][0] += s * w.x; acc[r][1] += s * w.y; acc[r][2] += s * w.z; acc[r][3] += s * w.w;
    }
  }
  __syncthreads();
  float* red = (float*)smem;
#pragma unroll
  for (int r = 0; r < 9; ++r)
#pragma unroll
    for (int q = 0; q < 4; ++q) red[(kq * 9 + r) * 128 + l32 * 4 + q] = acc[r][q];
  __syncthreads();
  float* mod = (float*)(p.ws + OFF_MOD);
  for (int e = tid; e < 9 * 128; e += 256) {
    const int r = e / 128, col = e % 128;
    float s = p.ada_b[l * 6144 + cc * 128 + col];
#pragma unroll
    for (int q = 0; q < 8; ++q) s += red[(q * 9 + r) * 128 + col];
    mod[((size_t)l * 9 + r) * 6144 + cc * 128 + col] = s;
  }
}

PHASE_FN void phase0(const Params& p, char* smem, int bid, int nblk) {
  constexpr int N_ADA = 96, N_WIN = 16 * 73, N_WOUT = 24 * 16, N_POOL = 64;
  constexpr int total = N_ADA + N_WIN + N_WOUT + N_POOL;
  if (bid == nblk - 1) {
    uint4* z = (uint4*)((u16*)(p.ws + OFF_WIN) + (size_t)INW * 1024);
    for (int e = ltid(); e < (INWP - INW) * 1024 / 8; e += 512) z[e] = make_uint4(0, 0, 0, 0);
  }
  for (int it2 = bid; it2 < total / 2; it2 += nblk) {
    int id = it2 * 2;
    if (id < N_ADA) { phase_ada_item(p, id + vhalf(), smem); continue; }
    id -= N_ADA;
    if (id < N_WIN) { const int x = id + vhalf(); convert_tile(p.w_in, 1024, INW, (u16*)(p.ws + OFF_WIN), x / 73, x % 73, smem); continue; }
    id -= N_WIN;
    if (id < N_WOUT) { const int x = id + vhalf(); convert_tile(p.w_out, MIXW, 1024, (u16*)(p.ws + OFF_WOUT), x / 16, x % 16, smem); continue; }
    id -= N_WOUT;
    {
      const int x = id + vhalf();
      const int g = x / 16, r = x % 16;
      convert_tile(p.pool_w + (size_t)g * 65536, 256, 256, (u16*)(p.ws + OFF_POOLT) + (size_t)g * 65536, r / 4, r % 4, smem);
    }
  }
}

DEV void ld8f(const float* p, float* v) {
  const float4 a = *(const float4*)p, b = *(const float4*)(p + 4);
  v[0] = a.x; v[1] = a.y; v[2] = a.z; v[3] = a.w; v[4] = b.x; v[5] = b.y; v[6] = b.z; v[7] = b.w;
}
DEV void load_row16(const float* src, int lane, float* v) {
#pragma unroll
  for (int s = 0; s < 4; ++s) {
    const float4 t = *(const float4*)(src + lane * 4 + 256 * s);
    v[s * 4 + 0] = t.x; v[s * 4 + 1] = t.y; v[s * 4 + 2] = t.z; v[s * 4 + 3] = t.w;
  }
}
DEV void norm_mod_store(const float* v, float rstd, const float* g, const float* shift, const float* scale, u16* dst, int lane) {
#pragma unroll
  for (int s = 0; s < 4; ++s) {
    const int c = lane * 4 + 256 * s;
    const float4 gg = *(const float4*)(g + c), sh = *(const float4*)(shift + c), sc = *(const float4*)(scale + c);
    const float h0 = v[s * 4 + 0] * rstd * gg.x * (1.f + sc.x) + sh.x;
    const float h1 = v[s * 4 + 1] * rstd * gg.y * (1.f + sc.y) + sh.y;
    const float h2 = v[s * 4 + 2] * rstd * gg.z * (1.f + sc.z) + sh.z;
    const float h3 = v[s * 4 + 3] * rstd * gg.w * (1.f + sc.w) + sh.w;
    uint2 o; o.x = pack2(h0, h1); o.y = pack2(h2, h3);
    *(uint2*)(dst + c) = o;
  }
}

DEV void norm_in_one(const Params& p, int row, int lane, const float* v) {
  const bool isctx = row >= NTOK;
  const int r = isctx ? row - NTOK : row;
  const int b = isctx ? 8 : r / SEQ;
  float ss = 0.f;
#pragma unroll
  for (int e = 0; e < 16; ++e) ss += v[e] * v[e];
  ss = wave_sum(ss);
  const float rstd = rsqrtf(ss * (1.f / D) + 1e-6f);
  const float* m = (const float*)(p.ws + OFF_MOD) + (size_t)b * 6144;
  u16* dst = isctx ? (u16*)(p.ws + OFF_HC) + (size_t)r * D : (u16*)(p.ws + OFF_HA) + (size_t)r * D;
#pragma unroll
  for (int s = 0; s < 2; ++s) {
    const int c = lane * 8 + 512 * s;
    float g[8], sh[8], sc[8], h[8];
    ld8f(p.norm_g + c, g);
    ld8f(m + c, sh);
    ld8f(m + 1024 + c, sc);
#pragma unroll
    for (int k = 0; k < 8; ++k) h[k] = v[s * 8 + k] * rstd * g[k] * (1.f + sc[k]) + sh[k];
    *(uint4*)(dst + c) = pack8(h);
  }
}

PHASE_FN void phase_norm_in(const Params& p, int bid, int nblk) {
  const int lane = ltid() & 63, gw = bid * 8 + (ltid() >> 6), nw = nblk * 8;
  for (int row = gw; row < NTOK + NCTX; row += 2 * nw) {
    const int row2 = row + nw;
    const bool has2 = row2 < NTOK + NCTX;
    float va[16], vb[16];
    const float* pa = row >= NTOK ? p.ctx + (size_t)(row - NTOK) * D : p.x + (size_t)row * D;
    ld8f(pa + lane * 8, va); ld8f(pa + lane * 8 + 512, va + 8);
    if (has2) {
      const float* pb = row2 >= NTOK ? p.ctx + (size_t)(row2 - NTOK) * D : p.x + (size_t)row2 * D;
      ld8f(pb + lane * 8, vb); ld8f(pb + lane * 8 + 512, vb + 8);
    }
    norm_in_one(p, row, lane, va);
    if (has2) norm_in_one(p, row2, lane, vb);
  }
}

template <bool IN_BF, bool OUT_BF>
PHASE_FN void phase_row_update(const Params& p, int bid, int nblk, const void* xin_, void* xout_, const float* gate_base,
                          const float* gpost, bool has_next, const float* gnext, const float* shift_base,
                          const float* scale_base) {
  const int lane = ltid() & 63, gw = bid * 8 + (ltid() >> 6), nw = nblk * 8;
  const u16* ybuf = (const u16*)(p.ws + OFF_YBUF);
  const float* ssq = (const float*)(p.ws + OFF_SSQ);
  u16* hout = (u16*)(p.ws + OFF_HA);
  float gp[16], gn[16];
#pragma unroll
  for (int s = 0; s < 2; ++s) {
    ld8f(gpost + lane * 8 + 512 * s, gp + s * 8);
    if (has_next) ld8f(gnext + lane * 8 + 512 * s, gn + s * 8);
    else {
#pragma unroll
      for (int k = 0; k < 8; ++k) gn[s * 8 + k] = 0.f;
    }
  }
  constexpr int R = 4;
  for (int row0 = gw; row0 < NTOK; row0 += R * nw) {
    float v[R][16];
    uint4 yy[R][2];
    float sy[R];
#pragma unroll
    for (int j = 0; j < R; ++j) {
      const int row = row0 + j * nw;
#pragma unroll
      for (int s = 0; s < 2; ++s) {
        const int c = lane * 8 + 512 * s;
        if (IN_BF) unpack8(*(const uint4*)((const u16*)xin_ + (size_t)row * D + c), v[j] + s * 8);
        else ld8f((const float*)xin_ + (size_t)row * D + c, v[j] + s * 8);
        yy[j][s] = *(const uint4*)(ybuf + (size_t)row * D + c);
      }
      sy[j] = (lane < 8) ? ssq[(size_t)row * 8 + lane] : 0.f;
    }
#pragma unroll
    for (int j = 0; j < R; ++j) {
      const int row = row0 + j * nw;
      const int b = row / SEQ;
      const float rstd_y = rsqrtf(wave_sum(sy[j]) * (1.f / D) + 1e-6f);
      const float* gate = gate_base + (size_t)b * 6144;
      float ss = 0.f;
#pragma unroll
      for (int s = 0; s < 2; ++s) {
        const int c = lane * 8 + 512 * s;
        float gt[8], yv[8];
        ld8f(gate + c, gt);
        unpack8(yy[j][s], yv);
#pragma unroll
        for (int k = 0; k < 8; ++k) v[j][s * 8 + k] += gt[k] * (yv[k] * rstd_y * gp[s * 8 + k]);
        if (OUT_BF) {
          const uint4 o = pack8(v[j] + s * 8);
          *(uint4*)((u16*)xout_ + (size_t)row * D + c) = o;
          unpack8(o, v[j] + s * 8);
        } else {
          float* xo = (float*)xout_ + (size_t)row * D + c;
          *(float4*)xo = make_float4(v[j][s * 8], v[j][s * 8 + 1], v[j][s * 8 + 2], v[j][s * 8 + 3]);
          *(float4*)(xo + 4) = make_float4(v[j][s * 8 + 4], v[j][s * 8 + 5], v[j][s * 8 + 6], v[j][s * 8 + 7]);
        }
#pragma unroll
        for (int k = 0; k < 8; ++k) ss += v[j][s * 8 + k] * v[j][s * 8 + k];
      }
      if (has_next) {
        const float rstd = rsqrtf(wave_sum(ss) * (1.f / D) + 1e-6f);
        const float* shift = shift_base + (size_t)b * 6144;
        const float* scale = scale_base + (size_t)b * 6144;
#pragma unroll
        for (int s = 0; s < 2; ++s) {
          const int c = lane * 8 + 512 * s;
          float sh[8], sc[8], h[8];
          ld8f(shift + c, sh);
          ld8f(scale + c, sc);
#pragma unroll
          for (int k = 0; k < 8; ++k) h[k] = v[j][s * 8 + k] * rstd * gn[s * 8 + k] * (1.f + sc[k]) + sh[k];
          *(uint4*)(hout + (size_t)row * D + c) = pack8(h);
        }
      }
    }
  }
}

struct TileIter {
  int chunk, local, nx, total, NI, NJ;
  DEV TileIter(int bid, int nblk, int NI_, int NJ_) : chunk(bid & 7), local(bid >> 3), nx(nblk >> 3), total(NI_ * NJ_), NI(NI_), NJ(NJ_) {}
  DEV bool next(int& it, int& jt) {
    const int idp = chunk * nx + local;
    if (chunk * nx >= total) return false;
    chunk += 8;
    if (idp >= total) { it = -1; return true; }
    const int fullp = NJ >> 3;
    const int nfull = fullp * NI * 8;
    if (idp < nfull) {
      const int panel = idp / (NI * 8), rem = idp - panel * (NI * 8);
      it = rem >> 3;
      jt = panel * 8 + (rem & 7);
    } else {
      const int pw = NJ - fullp * 8, rem = idp - nfull;
      it = rem / pw;
      jt = fullp * 8 + (rem - it * pw);
    }
    return true;
  }
};

struct EpiInproj {
  const Params* p; int c0; int t0; bool isctx;
  DEV f32x4 store(int i, int j, f32x4 v) {
    const int c = c0 + i, t = t0 + j;
    char* ws = p->ws;
    uint2 o; o.x = pack2(v[0], v[1]); o.y = pack2(v[2], v[3]);
    if (!isctx) {
      if (c < 512) *(uint2*)((u16*)(ws + OFF_QB) + (size_t)t * 512 + c) = o;
      else if (c < 1536) *(uint2*)((u16*)(ws + OFF_ZB) + (size_t)t * 1024 + (c - 512)) = o;
      else if (c < 2048) *(uint2*)((u16*)(ws + OFF_KB) + (size_t)t * 512 + (c - 1536)) = o;
      else if (c < 2560) *(uint2*)((u16*)(ws + OFF_VB) + (size_t)t * 512 + (c - 2048)) = o;
      else if (c < 4608) {
        *(uint2*)((u16*)(ws + OFF_XBC) + (size_t)t * XBCW + (c - 2560)) = o;
        const int seg = t >> 6, w = t & 63;
        u16* halo = (u16*)(ws + OFF_HALO);
        if (w == 63 && seg + 1 < 512) *(uint2*)(halo + ((size_t)(seg + 1) * 2 + 0) * XBCW + (c - 2560)) = o;
        if (w == 0 && seg > 0) *(uint2*)(halo + ((size_t)(seg - 1) * 2 + 1) * XBCW + (c - 2560)) = o;
      } else if (c < INW) *(float4*)((float*)(ws + OFF_DTRAW) + (size_t)t * 32 + (c - 4608)) = make_float4(v[0], v[1], v[2], v[3]);
    } else {
      if (c < 2048) *(uint2*)((u16*)(ws + OFF_KC) + (size_t)t * 512 + (c - 1536)) = o;
      else if (c < 2560) *(uint2*)((u16*)(ws + OFF_VC) + (size_t)t * 512 + (c - 2048)) = o;
      else if (c < 4608) {
        *(uint2*)((u16*)(ws + OFF_XBCC) + (size_t)t * XBCW + (c - 2560)) = o;
        const int seg = t >> 6, w = t & 63;
        u16* halo = (u16*)(ws + OFF_HALO) + (size_t)512 * 2 * XBCW;
        if (w == 63 && seg + 1 < 32) *(uint2*)(halo + ((size_t)(seg + 1) * 2 + 0) * XBCW + (c - 2560)) = o;
        if (w == 0 && seg > 0) *(uint2*)(halo + ((size_t)(seg - 1) * 2 + 1) * XBCW + (c - 2560)) = o;
      } else if (c < INW) *(float4*)((float*)(ws + OFF_DTRAWC) + (size_t)t * 32 + (c - 4608)) = make_float4(v[0], v[1], v[2], v[3]);
    }
    return v;
  }
  DEV void ssq(int, int, float) {}
  DEV bool wide() const { return c0 + 256 <= 4608; }
  DEV f32x4 xform(int, int, f32x4 v) const { return v; }
  DEV void store8(int i8, int j, uint4 o) {
    const int c = c0 + i8, t = t0 + j;
    char* ws = p->ws;
    if (!isctx) {
      if (c < 512) nt_store16((u16*)(ws + OFF_QB) + (size_t)t * 512 + c, o);
      else if (c < 1536) nt_store16((u16*)(ws + OFF_ZB) + (size_t)t * 1024 + (c - 512), o);
      else if (c < 2048) nt_store16((u16*)(ws + OFF_KB) + (size_t)t * 512 + (c - 1536), o);
      else if (c < 2560) nt_store16((u16*)(ws + OFF_VB) + (size_t)t * 512 + (c - 2048), o);
      else {
        nt_store16((u16*)(ws + OFF_XBC) + (size_t)t * XBCW + (c - 2560), o);
        const int seg = t >> 6, w = t & 63;
        u16* halo = (u16*)(ws + OFF_HALO);
        if (w == 63 && seg + 1 < 512) *(uint4*)(halo + ((size_t)(seg + 1) * 2 + 0) * XBCW + (c - 2560)) = o;
        if (w == 0 && seg > 0) *(uint4*)(halo + ((size_t)(seg - 1) * 2 + 1) * XBCW + (c - 2560)) = o;
      }
    } else {
      if (c < 2048) *(uint4*)((u16*)(ws + OFF_KC) + (size_t)t * 512 + (c - 1536)) = o;
      else if (c < 2560) *(uint4*)((u16*)(ws + OFF_VC) + (size_t)t * 512 + (c - 2048)) = o;
      else {
        *(uint4*)((u16*)(ws + OFF_XBCC) + (size_t)t * XBCW + (c - 2560)) = o;
        const int seg = t >> 6, w = t & 63;
        u16* halo = (u16*)(ws + OFF_HALO) + (size_t)512 * 2 * XBCW;
        if (w == 63 && seg + 1 < 32) *(uint4*)(halo + ((size_t)(seg + 1) * 2 + 0) * XBCW + (c - 2560)) = o;
        if (w == 0 && seg > 0) *(uint4*)(halo + ((size_t)(seg - 1) * 2 + 1) * XBCW + (c - 2560)) = o;
      }
    }
  }
};

PHASE_FN void phase_inproj(const Params& p, char* smem, int bid, int nblk) {
  constexpr int NI = INWP / 256, NJ = NTOK / 256, NIC = (INWP - 1536) / 256, NJC = NCTX / 256;
  const int total = NI * NJ + NIC * NJC;
  const u16* WinT = (const u16*)(p.ws + OFF_WIN);
  {
    TileIter ti(bid, nblk, NI, NJ);
    int it, jt;
    while (ti.next(it, jt)) {
      if (it < 0) continue;
      SrcPlain ps{WinT + (size_t)it * 256 * 1024, 1024};
      SrcPlain qs{(const u16*)(p.ws + OFF_HA) + (size_t)jt * 256 * 1024, 1024};
      EpiInproj epi{&p, it * 256, jt * 256, false};
      gemm_tile<false>(ps, qs, 1024, smem, epi);
    }
  }
  for (int id = NI * NJ + bid; id < total; id += nblk) {
    const int id2 = id - NI * NJ;
    const int it = id2 % NIC, jt = id2 / NIC;
    SrcPlain ps{WinT + (size_t)(1536 + it * 256) * 1024, 1024};
    SrcPlain qs{(const u16*)(p.ws + OFF_HC) + (size_t)jt * 256 * 1024, 1024};
    EpiInproj epi{&p, 1536 + it * 256, jt * 256, true};
    gemm_tile<false>(ps, qs, 1024, smem, epi);
  }
}

DEV void transpose_v_tile(const u16* src, u16* dst, int L, char* smem) {
  u16(*t)[72] = (u16(*)[72])(smem + vhalf() * 16384);
  const int tid = vtid();
  __syncthreads();
  {
    const int row = tid >> 2, c16 = (tid & 3) * 16;
    const uint4 a = *(const uint4*)(src + (size_t)row * 512 + c16);
    const uint4 b = *(const uint4*)(src + (size_t)row * 512 + c16 + 8);
    *(uint4*)(&t[row][c16]) = a;
    *(uint4*)(&t[row][c16 + 8]) = b;
  }
  __syncthreads();
  {
    const int d = tid >> 2, t16 = (tid & 3) * 16;
    unsigned o[8];
#pragma unroll
    for (int e = 0; e < 8; ++e) o[e] = (unsigned)t[t16 + 2 * e][d] | ((unsigned)t[t16 + 2 * e + 1][d] << 16);
    *(uint4*)(dst + (size_t)d * L + t16) = make_uint4(o[0], o[1], o[2], o[3]);
    *(uint4*)(dst + (size_t)d * L + t16 + 8) = make_uint4(o[4], o[5], o[6], o[7]);
  }
}

PHASE_FN void phase_conv(const Params& p, char* smem, int bid, int nblk) {
  const int tid = vtid();
  const int c8 = tid * 8;
  constexpr int NSEG = 512 + 32, NVT = 4096, NVCT = 256;
  unsigned* qc = (unsigned*)(p.ws + OFF_CNT) + 18;
  int* shq = (int*)(smem + 140000);
  for (;;) {
    __syncthreads();
    if (ltid() == 0) *shq = (int)atomicAdd(qc, 1u);
    __syncthreads();
    const int it2 = *shq;
    if (it2 >= (NSEG + NVT + NVCT) / 2) break;
    const int it = it2 * 2 + vhalf();
    if (it >= NSEG) {
      int id = it - NSEG;
      if (id < NVT) {
        const int tt = id & 63, h = (id >> 6) & 7, b = id >> 9;
        transpose_v_tile((const u16*)(p.ws + OFF_VB) + ((size_t)b * SEQ + tt * 64) * 512 + h * 64,
                         (u16*)(p.ws + OFF_VT) + ((size_t)(b * 8 + h) * 64) * SEQ + tt * 64, SEQ, smem);
      } else {
        id -= NVT;
        const int tt = id & 3, h = (id >> 2) & 7, b = id >> 5;
        transpose_v_tile((const u16*)(p.ws + OFF_VC) + ((size_t)b * CTXL + tt * 64) * 512 + h * 64,
                         (u16*)(p.ws + OFF_VCT) + ((size_t)(b * 8 + h) * 64) * CTXL + tt * 64, CTXL, smem);
      }
      continue;
    }
    const int seg = it;
    float w0[8], w1[8], w2[8], bb[8];
#pragma unroll
    for (int e = 0; e < 8; ++e) {
      w0[e] = p.conv_w[c8 + e]; w1[e] = p.conv_w[XBCW + c8 + e]; w2[e] = p.conv_w[2 * XBCW + c8 + e]; bb[e] = p.conv_b[c8 + e];
    }
    const bool isctx = seg >= 512;
    const int sl = isctx ? seg - 512 : seg;
    u16* base = (isctx ? (u16*)(p.ws + OFF_XBCC) : (u16*)(p.ws + OFF_XBC)) + (size_t)sl * 64 * XBCW + c8;
    const u16* halo = (const u16*)(p.ws + OFF_HALO) + (size_t)seg * 2 * XBCW + c8;
    const int L = isctx ? CTXL : SEQ;
    const int tin0 = (sl * 64) % L;
    uint4 prevraw = make_uint4(0, 0, 0, 0);
    if (tin0 != 0) prevraw = *(const uint4*)(halo);
    uint4 lastraw = make_uint4(0, 0, 0, 0);
    if (tin0 + 64 != L) lastraw = *(const uint4*)(halo + XBCW);
    for (int sb = 0; sb < 8; ++sb) {
      uint4 raw[9];
#pragma unroll
      for (int r = 0; r < 8; ++r) raw[r] = *(const uint4*)(base + (size_t)(sb * 8 + r) * XBCW);
      raw[8] = (sb < 7) ? *(const uint4*)(base + (size_t)(sb * 8 + 8) * XBCW) : lastraw;
      float prev[8], cur[8], nxt[8];
      unpack8(prevraw, prev);
      unpack8(raw[0], cur);
#pragma unroll
      for (int r = 0; r < 8; ++r) {
        unpack8(raw[r + 1], nxt);
        float o[8];
#pragma unroll
        for (int e = 0; e < 8; ++e) o[e] = silu_f(w0[e] * prev[e] + w1[e] * cur[e] + w2[e] * nxt[e] + bb[e]);
        *(uint4*)(base + (size_t)(sb * 8 + r) * XBCW) = pack8(o);
#pragma unroll
        for (int e = 0; e < 8; ++e) { prev[e] = cur[e]; cur[e] = nxt[e]; }
      }
      prevraw = raw[7];
    }
  }
}

DEV void ssd_naive_item(const Params& p, int item, char* smem) {
  const int tid = ltid();
  const int dir = item & 1, h = (item >> 1) & 15, b = item >> 5;
  const int g = h >> 2;
  const int pp = tid >> 2, nq = tid & 3;
  const float A = __expf(p.a_log[dir * 16 + h]);
  const float dtb = p.dt_bias[dir * 16 + h];
  float st[32];
#pragma unroll
  for (int e = 0; e < 32; ++e) st[e] = 0.f;
  u16* sx = (u16*)smem;
  float* sdt = (float*)(smem + 32 * 640);
  u16* Yd = (u16*)(p.ws + (dir ? OFF_Y1 : OFF_Y0));
  for (int part = 0; part < 2; ++part) {
    const int L = part == 0 ? CTXL : SEQ;
    const u16* xb = part == 0 ? (const u16*)(p.ws + OFF_XBCC) + (size_t)b * CTXL * XBCW
                              : (const u16*)(p.ws + OFF_XBC) + (size_t)b * SEQ * XBCW;
    const float* dtr = part == 0 ? (const float*)(p.ws + OFF_DTRAWC) + (size_t)b * CTXL * 32
                                 : (const float*)(p.ws + OFF_DTRAW) + (size_t)b * SEQ * 32;
    for (int s0 = 0; s0 < L; s0 += 32) {
      __syncthreads();
      for (int e = tid; e < 32 * 40; e += 256) {
        const int s = e / 40, ch = e % 40;
        const int t = dir ? (L - 1 - (s0 + s)) : (s0 + s);
        const u16* row = xb + (size_t)t * XBCW;
        const u16* src = ch < 8 ? row + h * 64 + ch * 8 : (ch < 24 ? row + 1024 + g * 128 + (ch - 8) * 8 : row + 1536 + g * 128 + (ch - 24) * 8);
        *(uint4*)(sx + s * 320 + ch * 8) = *(const uint4*)src;
      }
      if (tid < 32) {
        const int t = dir ? (L - 1 - (s0 + tid)) : (s0 + tid);
        const float dt = softplus_f(dtr[(size_t)t * 32 + dir * 16 + h] + dtb);
        sdt[tid] = dt;
        sdt[32 + tid] = __expf(-dt * A);
      }
      __syncthreads();
      for (int s = 0; s < 32; ++s) {
        const float dt = sdt[s], dec = sdt[32 + s];
        const float xdt = bf2f(sx[s * 320 + pp]) * dt;
        float y = 0.f;
        const u16* Bp = sx + s * 320 + 64 + nq * 32;
        const u16* Cp = sx + s * 320 + 192 + nq * 32;
#pragma unroll
        for (int q = 0; q < 4; ++q) {
          float bv[8], cv[8];
          unpack8(*(const uint4*)(Bp + q * 8), bv);
          unpack8(*(const uint4*)(Cp + q * 8), cv);
#pragma unroll
          for (int e = 0; e < 8; ++e) {
            st[q * 8 + e] = st[q * 8 + e] * dec + bv[e] * xdt;
            y += cv[e] * st[q * 8 + e];
          }
        }
        if (part == 1) {
          y += __shfl_xor(y, 1);
          y += __shfl_xor(y, 2);
          if (nq == 0) {
            const int t = dir ? (L - 1 - (s0 + s)) : (s0 + s);
            Yd[((size_t)b * SEQ + t) * 1024 + h * 64 + pp] = f2bf(y);
          }
        }
      }
    }
  }
}

DEV void ssd_mfma_item(const Params& p, int item, char* smem) {
  const int tid = vtid(), lane = tid & 63, w = tid >> 6, lr = lane & 15, lq = lane >> 4;
  smem += vhalf() * 69632;
  const int dir = item & 1, h = (item >> 1) & 15, b = item >> 5, g = h >> 2;
  const float A = __expf(p.a_log[dir * 16 + h]);
  const float dtb = p.dt_bias[dir * 16 + h];
  char* Bs = smem;
  char* Ss0 = smem + 16384;
  char* Xd = smem + 32768;
  char* Xw = smem + 40960;
  float* acs = (float*)(smem + 49152);
  float* sdt = acs + 64;
  float* sw = acs + 128;
  float* se = acs + 192;
  f32x4 S[2][4];
#pragma unroll
  for (int i = 0; i < 2; ++i)
#pragma unroll
    for (int pt = 0; pt < 4; ++pt) S[i][pt] = f32x4{0.f, 0.f, 0.f, 0.f};
  u16* Yd = (u16*)(p.ws + (dir ? OFF_Y1 : OFF_Y0));
  const int trq = lr >> 2, trp = lr & 3;
  const int trrow = lq * 4 + trq;
  const int sw1 = ((trrow >> 1) & 3) << 1, sw2 = (trrow & 7) << 1, sw3 = (lr & 7) << 1;
  const int xoff0 = trrow * 128 + (((0 + (trp >> 1)) ^ sw1) << 4) + 8 * (trp & 1);
  const int xoff1 = trrow * 128 + (((2 + (trp >> 1)) ^ sw1) << 4) + 8 * (trp & 1);
  const int xoff2 = trrow * 128 + (((4 + (trp >> 1)) ^ sw1) << 4) + 8 * (trp & 1);
  const int xoff3 = trrow * 128 + (((6 + (trp >> 1)) ^ sw1) << 4) + 8 * (trp & 1);
  const int boffA = trrow * 256 + ((((2 * w) * 2 + (trp >> 1)) ^ sw2) << 4) + 8 * (trp & 1);
  const int boffB = trrow * 256 + ((((2 * w + 1) * 2 + (trp >> 1)) ^ sw2) << 4) + 8 * (trp & 1);
  const int roff0 = lr * 256 + (((0 + lq) ^ sw3) << 4), roff1 = lr * 256 + (((4 + lq) ^ sw3) << 4);
  const int roff2 = lr * 256 + (((8 + lq) ^ sw3) << 4), roff3 = lr * 256 + (((12 + lq) ^ sw3) << 4);
  const int woffA = lr * 256 + ((((2 * w) * 2 + (lq >> 1)) ^ sw3) << 4) + 8 * (lq & 1);
  const int woffB = lr * 256 + ((((2 * w + 1) * 2 + (lq >> 1)) ^ sw3) << 4) + 8 * (lq & 1);
#define XOFF(pt_) ((pt_) == 0 ? xoff0 : (pt_) == 1 ? xoff1 : (pt_) == 2 ? xoff2 : xoff3)
#define ROFF(ks_) ((ks_) == 0 ? roff0 : (ks_) == 1 ? roff1 : (ks_) == 2 ? roff2 : roff3)
#define TMAPX(tb_, s_) (dir ? ((tb_) + 63 - (s_)) : ((tb_) + (s_)))
#define CH_ISCTX(c_) ((c_) < 4)
#define CH_TBASE(c_) (CH_ISCTX(c_) ? (dir ? (CTXL - 64 - (c_) * 64) : (c_) * 64) : (dir ? (SEQ - 64 - ((c_) - 4) * 64) : ((c_) - 4) * 64))
#define CH_XB(c_) (CH_ISCTX(c_) ? (const u16*)(p.ws + OFF_XBCC) + (size_t)b * CTXL * XBCW : (const u16*)(p.ws + OFF_XBC) + (size_t)b * SEQ * XBCW)
#define CH_DTR(c_) (CH_ISCTX(c_) ? (const float*)(p.ws + OFF_DTRAWC) + (size_t)b * CTXL * 32 : (const float*)(p.ws + OFF_DTRAW) + (size_t)b * SEQ * 32)
#define SSD_OFF(t_, col_) ((unsigned)(((t_) * XBCW + (col_)) * 2))
#define SSD_LOAD(c_)                                                                                        \
  {                                                                                                         \
    const char* xb_ = (const char*)(CH_XB(c_)); const int tb_ = CH_TBASE(c_);                               \
    xr0 = *(const uint4*)(xb_ + SSD_OFF(TMAPX(tb_, (tid >> 3)), h * 64 + (tid & 7) * 8));                   \
    xr1 = *(const uint4*)(xb_ + SSD_OFF(TMAPX(tb_, (tid >> 3) + 32), h * 64 + (tid & 7) * 8));              \
    br0 = *(const uint4*)(xb_ + SSD_OFF(TMAPX(tb_, (tid >> 4)), 1024 + g * 128 + (tid & 15) * 8));          \
    br1 = *(const uint4*)(xb_ + SSD_OFF(TMAPX(tb_, (tid >> 4) + 16), 1024 + g * 128 + (tid & 15) * 8));     \
    br2 = *(const uint4*)(xb_ + SSD_OFF(TMAPX(tb_, (tid >> 4) + 32), 1024 + g * 128 + (tid & 15) * 8));     \
    br3 = *(const uint4*)(xb_ + SSD_OFF(TMAPX(tb_, (tid >> 4) + 48), 1024 + g * 128 + (tid & 15) * 8));     \
    if (!CH_ISCTX(c_)) {                                                                                    \
      const char* crow_ = xb_ + SSD_OFF(TMAPX(tb_, w * 16 + lr), 1536 + g * 128 + lq * 8);                  \
      cfn0 = *(const bf16x8*)(crow_); cfn1 = *(const bf16x8*)(crow_ + 64);                                  \
      cfn2 = *(const bf16x8*)(crow_ + 128); cfn3 = *(const bf16x8*)(crow_ + 192);                           \
    }                                                                                                       \
    dtn = *(const float*)((const char*)(CH_DTR(c_)) + (unsigned)((TMAPX(tb_, lane) * 32 + dir * 16 + h) * 4)); \
  }
  uint4 xr0, xr1, br0, br1, br2, br3;
  bf16x8 cfn0 = {}, cfn1 = {}, cfn2 = {}, cfn3 = {};
  float dtn = 0.f;
  SSD_LOAD(0)
  for (int ch = 0; ch < 68; ++ch) {
    const bool isctx = ch < 4;
    const int tbase = CH_TBASE(ch);
#define TMAP(s_) TMAPX(tbase, s_)
    bf16x8 cf[4];
    cf[0] = cfn0; cf[1] = cfn1; cf[2] = cfn2; cf[3] = cfn3;
    const float dtraw_cur = dtn;
    const float dt_l = softplus_f(dtraw_cur + dtb);
    float cs_l = -dt_l * A;
#pragma unroll
    for (int o = 1; o < 64; o <<= 1) {
      const float t = __shfl_up(cs_l, o);
      if (lane >= o) cs_l += t;
    }
    const float tot_l = __uint_as_float(__builtin_amdgcn_readlane(__float_as_uint(cs_l), 63));
    const float w_l = __expf(tot_l - cs_l), e_l = __expf(cs_l);
    const float dec = __uint_as_float(__builtin_amdgcn_readlane(__float_as_uint(e_l), 63));
    char* SsR = Ss0 + (ch & 1) * 36864;
    char* SsW = Ss0 + ((ch + 1) & 1) * 36864;
    lds_barrier();
    if (w == 0) { acs[lane] = cs_l; se[lane] = e_l; }
#define SSD_XST(XR, i_)                                                      \
    {                                                                        \
      const int s_ = (tid >> 3) + 32 * (i_), c = tid & 7;                    \
      float f[8], fw[8];                                                     \
      unpack8(XR, f);                                                        \
      const float d = __shfl(dt_l, s_), ww = __shfl(w_l, s_);                \
      _Pragma("unroll") for (int e = 0; e < 8; ++e) { f[e] *= d; fw[e] = f[e] * ww; } \
      const int off = s_ * 128 + ((c ^ (((s_ >> 1) & 3) << 1)) << 4);        \
      *(uint4*)(Xd + off) = pack8(f);                                        \
      *(uint4*)(Xw + off) = pack8(fw);                                       \
    }
    SSD_XST(xr0, 0) SSD_XST(xr1, 1)
#undef SSD_XST
#define SSD_BST(BR, i_) { const int s_ = (tid >> 4) + 16 * (i_), c = tid & 15; *(uint4*)(Bs + s_ * 256 + ((c ^ ((s_ & 7) << 1)) << 4)) = BR; }
    SSD_BST(br0, 0) SSD_BST(br1, 1) SSD_BST(br2, 2) SSD_BST(br3, 3)
#undef SSD_BST
    lds_barrier();
    if (ch + 1 < 68) { SSD_LOAD(ch + 1) }
    if (!isctx) {
      f32x4 G[4];
      {
        bf16x8 ga[4][4];
#pragma unroll
        for (int j = 0; j < 4; ++j)
#pragma unroll
          for (int ks = 0; ks < 4; ++ks) ga[j][ks] = *(const bf16x8*)(Bs + j * 4096 + ROFF(ks));
        const float la = acs[w * 16 + lr];
        float4 sa4[4];
#pragma unroll
        for (int j = 0; j < 4; ++j) sa4[j] = *(const float4*)(acs + j * 16 + lq * 4);
        __builtin_amdgcn_sched_barrier(0);
#pragma unroll
        for (int j = 0; j < 4; ++j) {
          G[j] = f32x4{0.f, 0.f, 0.f, 0.f};
          if (j <= w) {
#pragma unroll
            for (int ks = 0; ks < 4; ++ks) G[j] = __builtin_amdgcn_mfma_f32_16x16x32_bf16(ga[j][ks], cf[ks], G[j], 0, 0, 0);
          }
        }
#pragma unroll
        for (int j = 0; j < 4; ++j) {
          if (j <= w) {
            const float sv[4] = {sa4[j].x, sa4[j].y, sa4[j].z, sa4[j].w};
#pragma unroll
            for (int r = 0; r < 4; ++r) {
              const bool keep = (j < w) || (lq * 4 + r <= lr);
              const float ev = __expf(fminf(la - sv[r], 0.f));
              G[j][r] = keep ? G[j][r] * ev : 0.f;
            }
          }
        }
      }
      bf16x8 Mf[2];
#pragma unroll
      for (int kk = 0; kk < 2; ++kk) {
        const unsigned u0 = pack2(G[2 * kk][0], G[2 * kk][1]), u1 = pack2(G[2 * kk][2], G[2 * kk][3]);
        const unsigned u2 = pack2(G[2 * kk + 1][0], G[2 * kk + 1][1]), u3 = pack2(G[2 * kk + 1][2], G[2 * kk + 1][3]);
        const uint4 u = make_uint4(u0, u1, u2, u3);
        Mf[kk] = __builtin_bit_cast(bf16x8, u);
      }
      f32x4 Y[4];
      const float4 evv = *(const float4*)(se + w * 16 + lq * 4);
      {
        bf16x8 sb[4][4];
#pragma unroll
        for (int pt = 0; pt < 4; ++pt)
#pragma unroll
          for (int ks = 0; ks < 4; ++ks) sb[pt][ks] = *(const bf16x8*)(SsR + pt * 4096 + ROFF(ks));
        __builtin_amdgcn_sched_barrier(0);
#pragma unroll
        for (int pt = 0; pt < 4; ++pt) {
          Y[pt] = f32x4{0.f, 0.f, 0.f, 0.f};
#pragma unroll
          for (int ks = 0; ks < 4; ++ks) Y[pt] = __builtin_amdgcn_mfma_f32_16x16x32_bf16(cf[ks], sb[pt][ks], Y[pt], 0, 0, 0);
          Y[pt][0] *= evv.x; Y[pt][1] *= evv.y; Y[pt][2] *= evv.z; Y[pt][3] *= evv.w;
        }
      }
      {
        s16x4 xt[2][4][2];
#pragma unroll
        for (int kk = 0; kk < 2; ++kk)
#pragma unroll
          for (int pt = 0; pt < 4; ++pt) {
            xt[kk][pt][0] = lds_tr(Xd + kk * 4096 + XOFF(pt));
            xt[kk][pt][1] = lds_tr(Xd + kk * 4096 + 2048 + XOFF(pt));
          }
        __builtin_amdgcn_sched_barrier(0);
#pragma unroll
        for (int kk = 0; kk < 2; ++kk) {
          if (kk * 2 <= w) {
#pragma unroll
            for (int pt = 0; pt < 4; ++pt)
              Y[pt] = __builtin_amdgcn_mfma_f32_16x16x32_bf16(Mf[kk], cat4(xt[kk][pt][0], xt[kk][pt][1]), Y[pt], 0, 0, 0);
          }
        }
      }
      {
        const int tq = TMAP(w * 16 + lq * 4 + (lr & 3));
        u16* yrow = Yd + ((size_t)b * SEQ + tq) * 1024 + h * 64 + (lr & 12);
#pragma unroll
        for (int pt = 0; pt < 4; ++pt) {
          float v0 = Y[pt][0], v1 = Y[pt][1], v2 = Y[pt][2], v3 = Y[pt][3];
          {
            const float s0 = (lane & 1) ? v0 : v1, s1 = (lane & 1) ? v2 : v3;
            const float r0 = __shfl_xor(s0, 1), r1 = __shfl_xor(s1, 1);
            if (lane & 1) { v0 = r0; v2 = r1; } else { v1 = r0; v3 = r1; }
          }
          {
            const float s0 = (lane & 2) ? v0 : v2, s1 = (lane & 2) ? v1 : v3;
            const float r0 = __shfl_xor(s0, 2), r1 = __shfl_xor(s1, 2);
            if (lane & 2) { v0 = r0; v1 = r1; } else { v2 = r0; v3 = r1; }
          }
          uint2 o; o.x = pack2(v0, v1); o.y = pack2(v2, v3);
          *(uint2*)(yrow + pt * 16) = o;
        }
      }
    }
    {
#pragma unroll
      for (int i = 0; i < 2; ++i)
#pragma unroll
        for (int pt = 0; pt < 4; ++pt) { S[i][pt][0] *= dec; S[i][pt][1] *= dec; S[i][pt][2] *= dec; S[i][pt][3] *= dec; }
      {
        s16x4 xw[2][4][2], bt[2][2][2];
#pragma unroll
        for (int k2 = 0; k2 < 2; ++k2) {
#pragma unroll
          for (int pt = 0; pt < 4; ++pt) {
            xw[k2][pt][0] = lds_tr(Xw + k2 * 4096 + XOFF(pt));
            xw[k2][pt][1] = lds_tr(Xw + k2 * 4096 + 2048 + XOFF(pt));
          }
          bt[k2][0][0] = lds_tr(Bs + k2 * 8192 + boffA);
          bt[k2][0][1] = lds_tr(Bs + k2 * 8192 + 4096 + boffA);
          bt[k2][1][0] = lds_tr(Bs + k2 * 8192 + boffB);
          bt[k2][1][1] = lds_tr(Bs + k2 * 8192 + 4096 + boffB);
        }
        __builtin_amdgcn_sched_barrier(0);
#pragma unroll
        for (int k2 = 0; k2 < 2; ++k2)
#pragma unroll
          for (int i = 0; i < 2; ++i) {
            const bf16x8 af = cat4(bt[k2][i][0], bt[k2][i][1]);
#pragma unroll
            for (int pt = 0; pt < 4; ++pt)
              S[i][pt] = __builtin_amdgcn_mfma_f32_16x16x32_bf16(af, cat4(xw[k2][pt][0], xw[k2][pt][1]), S[i][pt], 0, 0, 0);
          }
      }
#pragma unroll
      for (int i = 0; i < 2; ++i)
#pragma unroll
        for (int pt = 0; pt < 4; ++pt) {
          uint2 o; o.x = pack2(S[i][pt][0], S[i][pt][1]); o.y = pack2(S[i][pt][2], S[i][pt][3]);
          *(uint2*)(SsW + pt * 4096 + (i == 0 ? woffA : woffB)) = o;
        }
    }
#undef TMAP
  }
#undef SSD_LOAD
#undef SSD_OFF
#undef XOFF
#undef ROFF
#undef CH_DTR
#undef CH_XB
#undef CH_TBASE
#undef CH_ISCTX
#undef TMAPX
  __syncthreads();
}

DEV void attn_naive(const Params& p, int gw, int nw) {
  const int lane = ltid() & 63;
  u16* Qb = (u16*)(p.ws + OFF_QB);
  const u16* Kb = (const u16*)(p.ws + OFF_KB);
  const u16* Vb = (const u16*)(p.ws + OFF_VB);
  const u16* Kc = (const u16*)(p.ws + OFF_KC);
  const u16* Vc = (const u16*)(p.ws + OFF_VC);
  for (int pair = gw; pair < NTOK * 8; pair += nw) {
    const int token = pair >> 3, h = pair & 7;
    const int b = token / SEQ, t = token % SEQ, r = t >> 6, qc = t & 63;
    const int rs = min(max(r - 4, 0), 56), cs = min(max(qc - 8, 0), 48);
    const float qv = bf2f(Qb[(size_t)token * 512 + h * 64 + lane]);
    float sc[6];
    const u16* kptr[6];
#pragma unroll
    for (int s = 0; s < 6; ++s) {
      const int kk = lane + 64 * s;
      if (s < 2) {
        const int wr = kk >> 4, wc = kk & 15;
        const int kt = b * SEQ + (rs + wr) * 64 + cs + wc;
        kptr[s] = Kb + (size_t)kt * 512 + h * 64;
        sc[s] = p.na_rpb[(h * 15 + (rs + wr - r + 7)) * 31 + (cs + wc - qc + 15)];
      } else {
        kptr[s] = Kc + (size_t)(b * CTXL + kk - 128) * 512 + h * 64;
        sc[s] = 0.f;
      }
    }
    float dot[6] = {0.f, 0.f, 0.f, 0.f, 0.f, 0.f};
#pragma unroll
    for (int d8 = 0; d8 < 8; ++d8) {
      float qd[8];
#pragma unroll
      for (int e = 0; e < 8; ++e) qd[e] = __shfl(qv, d8 * 8 + e);
#pragma unroll
      for (int s = 0; s < 6; ++s) {
        float kv[8];
        unpack8(*(const uint4*)(kptr[s] + d8 * 8), kv);
#pragma unroll
        for (int e = 0; e < 8; ++e) dot[s] += qd[e] * kv[e];
      }
    }
    float m = -1e30f;
#pragma unroll
    for (int s = 0; s < 6; ++s) { sc[s] += dot[s] * 0.125f; m = fmaxf(m, sc[s]); }
    m = wave_max(m);
    float sum = 0.f;
#pragma unroll
    for (int s = 0; s < 6; ++s) { sc[s] = __expf(sc[s] - m); sum += sc[s]; }
    sum = wave_sum(sum);
    float o = 0.f;
#pragma unroll
    for (int s = 0; s < 6; ++s) {
      for (int src = 0; src < 64; ++src) {
        const float pv = __shfl(sc[s], src);
        const int kk = src + 64 * s;
        const u16* vp;
        if (s < 2) {
          const int wr = kk >> 4, wc = kk & 15;
          vp = Vb + (size_t)(b * SEQ + (rs + wr) * 64 + cs + wc) * 512 + h * 64;
        } else vp = Vc + (size_t)(b * CTXL + kk - 128) * 512 + h * 64;
        o += pv * bf2f(vp[lane]);
      }
    }
    Qb[(size_t)token * 512 + h * 64 + lane] = f2bf(o / sum);
  }
}

DEV void attn_mfma_unit(const Params& p, int bu, char* smem) {
  const int tid = vtid(), lane = tid & 63, w = tid >> 6, lr = lane & 15, lq = lane >> 4;
  smem += vhalf() * 36864;
  const int r = bu & 63, h = (bu >> 6) & 7, b = bu >> 9;
  const int q0 = w * 16, kc0 = min(max(q0 - 8, 0), 32), rs = min(max(r - 4, 0), 56);
  const int qcol = q0 + lr, cs = min(max(qcol - 8, 0), 48);
  u16* Qb = (u16*)(p.ws + OFF_QB);
  const size_t qtok = (size_t)b * SEQ + r * 64 + qcol;
  bf16x8 qf[2];
  qf[0] = *(const bf16x8*)(Qb + qtok * 512 + h * 64 + lq * 8);
  qf[1] = *(const bf16x8*)(Qb + qtok * 512 + h * 64 + 32 + lq * 8);
  f32x4 O[4];
#pragma unroll
  for (int dt = 0; dt < 4; ++dt) O[dt] = f32x4{0.f, 0.f, 0.f, 0.f};
  float m = -1e30f, lsum = 0.f;
  const float LOG2E = 1.44269504089f;
  const float sc = 0.125f * LOG2E;
  const float* rpb = p.na_rpb + h * 15 * 31;
  const int koff0 = (lr >> 2) * 8 + (lr & 3), koff1 = koff0 + 4;
  int bcol[8];
  bool bval[8];
#pragma unroll
  for (int e = 0; e < 8; ++e) {
    const int kc = kc0 + lq * 8 + e;
    bval[e] = (unsigned)(kc - cs) < 16u;
    bcol[e] = bval[e] ? (kc - qcol + 15) : 0;
  }
  const int srow = tid >> 2, sc0 = (tid & 3) * 2;
  const u16* Kb = (const u16*)(p.ws + OFF_KB) + ((size_t)b * SEQ * 512 + h * 64);
  const u16* Kc = (const u16*)(p.ws + OFF_KC) + ((size_t)b * CTXL * 512 + h * 64);
  const u16* VT = (const u16*)(p.ws + OFF_VT) + ((size_t)(b * 8 + h) * 64 + srow) * SEQ;
  const u16* VcT = (const u16*)(p.ws + OFF_VCT) + ((size_t)(b * 8 + h) * 64 + srow) * CTXL;
  uint4 sk0A, sk1A, sv0A, sv1A, sk0B, sk1B, sv0B, sv1B, sk0C, sk1C, sv0C, sv1C;
#define AT_LOAD(st_, S)                                                                         \
  {                                                                                             \
    if ((st_) < 8) {                                                                            \
      const u16* kp_ = Kb + (size_t)((rs + (st_)) * 64 + srow) * 512 + sc0 * 8;                 \
      const u16* vp_ = VT + (rs + (st_)) * 64 + sc0 * 8;                                        \
      sk0##S = *(const uint4*)kp_; sk1##S = *(const uint4*)(kp_ + 8);                           \
      sv0##S = *(const uint4*)vp_; sv1##S = *(const uint4*)(vp_ + 8);                           \
    } else {                                                                                    \
      const u16* kp_ = Kc + (size_t)(((st_) - 8) * 64 + srow) * 512 + sc0 * 8;                  \
      const u16* vp_ = VcT + ((st_) - 8) * 64 + sc0 * 8;                                        \
      sk0##S = *(const uint4*)kp_; sk1##S = *(const uint4*)(kp_ + 8);                           \
      sv0##S = *(const uint4*)vp_; sv1##S = *(const uint4*)(vp_ + 8);                           \
    }                                                                                           \
  }
#define AT_STORE(buf_, S)                                                                       \
  {                                                                                             \
    char* kb_ = smem + (buf_) * 16384 + srow * 128;                                             \
    *(uint4*)(kb_ + (((sc0) ^ (srow & 7)) << 4)) = sk0##S;                                      \
    *(uint4*)(kb_ + (((sc0 + 1) ^ (srow & 7)) << 4)) = sk1##S;                                  \
    *(uint4*)(kb_ + 8192 + (((sc0) ^ (srow & 7)) << 4)) = sv0##S;                               \
    *(uint4*)(kb_ + 8192 + (((sc0 + 1) ^ (srow & 7)) << 4)) = sv1##S;                           \
  }
#define AT_PAIR(islat_, st_, cb_, buf_)                                                         \
  {                                                                                             \
    float bb_[8];                                                                               \
    if (islat_) {                                                                               \
      const float* rp_ = rpb + (rs + (st_) - r + 7) * 31;                                       \
      _Pragma("unroll") for (int e = 0; e < 8; ++e) bb_[e] = rp_[bcol[e]];                      \
    }                                                                                           \
    const char* kt_ = smem + (buf_) * 16384;                                                    \
    const char* vt_ = kt_ + 8192;                                                               \
    const int r0_ = (cb_) + koff0, r1_ = (cb_) + koff1;                                         \
    const bf16x8 k00 = *(const bf16x8*)(kt_ + r0_ * 128 + (((lq) ^ (r0_ & 7)) << 4));           \
    const bf16x8 k01 = *(const bf16x8*)(kt_ + r0_ * 128 + (((4 + lq) ^ (r0_ & 7)) << 4));       \
    const bf16x8 k10 = *(const bf16x8*)(kt_ + r1_ * 128 + (((lq) ^ (r1_ & 7)) << 4));           \
    const bf16x8 k11 = *(const bf16x8*)(kt_ + r1_ * 128 + (((4 + lq) ^ (r1_ & 7)) << 4));       \
    const int vch_ = ((cb_) >> 3) + lq;                                                         \
    bf16x8 vf_[4];                                                                              \
    _Pragma("unroll") for (int dt = 0; dt < 4; ++dt) {                                          \
      const int d_ = dt * 16 + lr;                                                              \
      vf_[dt] = *(const bf16x8*)(vt_ + d_ * 128 + (((vch_) ^ (d_ & 7)) << 4));                  \
    }                                                                                           \
    f32x4 s0 = f32x4{0.f, 0.f, 0.f, 0.f}, s1 = s0;                                              \
    s0 = __builtin_amdgcn_mfma_f32_16x16x32_bf16(k00, qf[0], s0, 0, 0, 0);                      \
    s1 = __builtin_amdgcn_mfma_f32_16x16x32_bf16(k10, qf[0], s1, 0, 0, 0);                      \
    s0 = __builtin_amdgcn_mfma_f32_16x16x32_bf16(k01, qf[1], s0, 0, 0, 0);                      \
    s1 = __builtin_amdgcn_mfma_f32_16x16x32_bf16(k11, qf[1], s1, 0, 0, 0);                      \
    float v[8];                                                                                 \
    _Pragma("unroll") for (int e = 0; e < 4; ++e) { v[e] = s0[e] * sc; v[4 + e] = s1[e] * sc; } \
    if (islat_) {                                                                               \
      _Pragma("unroll") for (int e = 0; e < 8; ++e) v[e] = bval[e] ? v[e] + bb_[e] * LOG2E : -INFINITY; \
    }                                                                                           \
    float mx = v[0];                                                                            \
    _Pragma("unroll") for (int e = 1; e < 8; ++e) mx = fmaxf(mx, v[e]);                         \
    mx = max_x16(mx);                                                                           \
    mx = max_x32(mx);                                                                           \
    const float mnew = fmaxf(m, mx);                                                            \
    const float corr = __builtin_amdgcn_exp2f(m - mnew);                                                         \
    m = mnew;                                                                                   \
    float ps = 0.f;                                                                             \
    _Pragma("unroll") for (int e = 0; e < 8; ++e) { v[e] = __builtin_amdgcn_exp2f(v[e] - mnew); ps += v[e]; }    \
    lsum = lsum * corr + ps;                                                                    \
    const uint4 pu = make_uint4(pack2(v[0], v[1]), pack2(v[2], v[3]), pack2(v[4], v[5]), pack2(v[6], v[7])); \
    const bf16x8 pf = __builtin_bit_cast(bf16x8, pu);                                           \
    _Pragma("unroll") for (int dt = 0; dt < 4; ++dt) {                                          \
      O[dt][0] *= corr; O[dt][1] *= corr; O[dt][2] *= corr; O[dt][3] *= corr;                   \
      O[dt] = __builtin_amdgcn_mfma_f32_16x16x32_bf16(vf_[dt], pf, O[dt], 0, 0, 0);             \
    }                                                                                           \
  }
#define AT_STAGE(st_)                                                                           \
  if ((st_) < 8) {                                                                              \
    AT_PAIR(true, st_, kc0, (st_) & 1)                                                          \
  } else {                                                                                      \
    AT_PAIR(false, st_, 0, (st_) & 1)                                                           \
    AT_PAIR(false, st_, 32, (st_) & 1)                                                          \
  }
  lds_barrier();
  AT_LOAD(0, A)
  AT_LOAD(1, B)
  AT_LOAD(2, C)
  AT_STORE(0, A)
  lds_barrier();
#pragma unroll 1
  for (int st = 0; st < 12; st += 3) {
    if (st + 3 < 12) { AT_LOAD(st + 3, A) }
    AT_STAGE(st)
    AT_STORE((st + 1) & 1, B)
    lds_barrier();
    if (st + 4 < 12) { AT_LOAD(st + 4, B) }
    AT_STAGE(st + 1)
    AT_STORE((st + 2) & 1, C)
    lds_barrier();
    if (st + 5 < 12) { AT_LOAD(st + 5, C) }
    AT_STAGE(st + 2)
    if (st + 3 < 12) { AT_STORE((st + 3) & 1, A) }
    lds_barrier();
  }
#undef AT_STAGE
#undef AT_LOAD
#undef AT_STORE
#undef AT_PAIR
  lsum = sum_x16(lsum);
  lsum = sum_x32(lsum);
  const float inv = __builtin_amdgcn_rcpf(lsum);
#pragma unroll
  for (int dt = 0; dt < 4; ++dt) {
    uint2 o;
    o.x = pack2(O[dt][0] * inv, O[dt][1] * inv);
    o.y = pack2(O[dt][2] * inv, O[dt][3] * inv);
    *(uint2*)(Qb + qtok * 512 + h * 64 + dt * 16 + lq * 4) = o;
  }
}

PHASE_FN void phase_mixer(const Params& p, char* smem, int bid, int nblk) {
  for (int it = bid; it < 128; it += nblk) ssd_mfma_item(p, it * 2 + vhalf(), smem);
  unsigned* qcnt = (unsigned*)(p.ws + OFF_CNT) + 16;
  int* sh = (int*)(smem + 110592);
  for (;;) {
    lds_barrier();
    if (ltid() == 0) *sh = (int)atomicAdd(qcnt, 1u);
    lds_barrier();
    const int bu2 = *sh;
    if (bu2 >= NB * 8 * 64 / 2) break;
    attn_mfma_unit(p, bu2 * 2 + vhalf(), smem);
  }
}

PHASE_FN void phase_gated(const Params& p, char* smem, int bid, int nblk) {
  const int lane = ltid() & 63, gw = bid * 8 + (ltid() >> 6), nw = nblk * 8;
  u16* Y0 = (u16*)(p.ws + OFF_Y0);
  const u16* Y1 = (const u16*)(p.ws + OFF_Y1);
  const u16* Zb = (const u16*)(p.ws + OFF_ZB);
  const u16* Xs = (const u16*)(p.ws + OFF_XBC);
  for (int row = gw; row < NTOK; row += nw) {
    float yz[16], gs[2];
#pragma unroll
    for (int s = 0; s < 2; ++s) {
      const int c = lane * 8 + 512 * s;
      const int hh = c >> 6;
      const float dsk = p.ssm_d[hh] + p.ssm_d[16 + hh];
      float a[8], bq[8], z[8], xs[8];
      unpack8(*(const uint4*)(Y0 + (size_t)row * D + c), a);
      unpack8(*(const uint4*)(Y1 + (size_t)row * D + c), bq);
      unpack8(*(const uint4*)(Zb + (size_t)row * D + c), z);
      unpack8(*(const uint4*)(Xs + (size_t)row * XBCW + c), xs);
      float q = 0.f;
#pragma unroll
      for (int k = 0; k < 8; ++k) {
        const float y = a[k] + bq[k] + dsk * xs[k];
        yz[s * 8 + k] = y * silu_f(z[k]);
        q += yz[s * 8 + k] * yz[s * 8 + k];
      }
#pragma unroll
      for (int o = 16; o > 0; o >>= 1) q += __shfl_xor(q, o);
      gs[s] = q;
    }
#pragma unroll
    for (int s = 0; s < 2; ++s) {
      const int c = lane * 8 + 512 * s;
      const float rstd = rsqrtf(gs[s] * (1.f / 256.f) + 1e-6f);
      float g[8], o[8];
      ld8f(p.ssm_norm_g + c, g);
#pragma unroll
      for (int k = 0; k < 8; ++k) o[k] = yz[s * 8 + k] * rstd * g[k];
      *(uint4*)(Y0 + (size_t)row * D + c) = pack8(o);
    }
  }
}

constexpr int FFN_NUP = 16 * 88, FFN_NDN = 44 * 16;
constexpr int FFN_CONV_FIRST = FFN_NUP / 2, FFN_CONV_TOTAL = FFN_NUP + FFN_NDN;
DEV void ffn_convert_pair(const Params& p, int id2, char* smem) {
  const int id = id2 * 2 + vhalf();
  const int l = id / (FFN_NUP + FFN_NDN), r = id % (FFN_NUP + FFN_NDN);
  if (r < FFN_NUP) {
    const int nt = r % 88;
    convert_tile(p.w_up + (size_t)l * D * FFH2, D, FFH2, (u16*)(p.ws + OFF_WUP + l * WUP_SZ), r / 88, nt, smem,
                 nt < 44 ? (nt >> 1) * 256 + (nt & 1) * 64 : ((nt - 44) >> 1) * 256 + 128 + ((nt - 44) & 1) * 64);
  } else convert_tile(p.w_down + (size_t)l * FFH * D, FFH, D, (u16*)(p.ws + OFF_WDOWN + l * WDOWN_SZ), (r - FFN_NUP) / 16, (r - FFN_NUP) % 16, smem);
}

struct EpiY {
  u16* ybuf; float* ssqb; int c0; int t0; int it; const float* bias; const float* scale;
  DEV f32x4 store(int i, int j, f32x4 v) {
    const int c = c0 + i, t = t0 + j;
    if (bias) {
      const float4 bb = *(const float4*)(bias + c), sc = *(const float4*)(scale + c);
      v[0] = (v[0] + bb.x) * sc.x; v[1] = (v[1] + bb.y) * sc.y; v[2] = (v[2] + bb.z) * sc.z; v[3] = (v[3] + bb.w) * sc.w;
    }
    uint2 o; o.x = pack2(v[0], v[1]); o.y = pack2(v[2], v[3]);
    *(uint2*)(ybuf + (size_t)t * D + c) = o;
    return v;
  }
  DEV void ssq(int j, int wi, float s) { ssqb[(size_t)(t0 + j) * 8 + it * 2 + wi] = s; }
  DEV bool wide() const { return true; }
  DEV f32x4 xform(int i, int, f32x4 v) const {
    if (bias) {
      const int c = c0 + i;
      const float4 bb = *(const float4*)(bias + c), sc = *(const float4*)(scale + c);
      v[0] = (v[0] + bb.x) * sc.x; v[1] = (v[1] + bb.y) * sc.y; v[2] = (v[2] + bb.z) * sc.z; v[3] = (v[3] + bb.w) * sc.w;
    }
    return v;
  }
  DEV void store8(int i8, int j, uint4 o) { nt_store16(ybuf + (size_t)(t0 + j) * D + c0 + i8, o); }
};

PHASE_FN void phase_outproj(const Params& p, char* smem, int bid, int nblk) {
  for (int id2 = bid; id2 < FFN_CONV_FIRST; id2 += nblk) ffn_convert_pair(p, id2, smem);
  constexpr int NI = 4, NJ = NTOK / 256;
  const u16* WT = (const u16*)(p.ws + OFF_WOUT);
  TileIter ti(bid, nblk, NI, NJ);
  int it, jt;
  while (ti.next(it, jt)) {
    if (it < 0) continue;
    SrcPlain ps{WT + (size_t)it * 256 * MIXW, MIXW};
    SrcCat qs{(const u16*)(p.ws + OFF_QB) + (size_t)jt * 256 * 512, 512, 512, (const u16*)(p.ws + OFF_Y0) + (size_t)jt * 256 * D, D};
    EpiY epi{(u16*)(p.ws + OFF_YBUF), (float*)(p.ws + OFF_SSQ), it * 256, jt * 256, it, nullptr, nullptr};
    gemm_tile<true>(ps, qs, MIXW, smem, epi);
  }
}

PHASE_FN void phase_poolgemm(const Params& p, char* smem, int bid, int nblk) {
  constexpr int NI = 4, NJ = NTOK / 256;
  const u16* WT = (const u16*)(p.ws + OFF_POOLT);
  for (int id = bid; id < NI * NJ; id += nblk) {
    const int it = id % NI, jt = id / NI;
    SrcPlain ps{WT + (size_t)it * 65536, 256};
    SrcPlain qs{(const u16*)(p.ws + OFF_POOLED) + (size_t)jt * 256 * D + it * 256, D};
    EpiY epi{(u16*)(p.ws + OFF_YBUF), (float*)(p.ws + OFF_SSQ), it * 256, jt * 256, it, p.pool_b, p.pool_scale};
    gemm_tile<true>(ps, qs, 256, smem, epi);
  }
}

PHASE_FN void phase_up(const Params& p, char* smem, int bid, int nblk, int l) {
  constexpr int NI = FFH / 128, NJ = (NTOK + 253) / 254;
  const u16* WT = (const u16*)(p.ws + OFF_WUP + l * WUP_SZ);
  u16* gact = (u16*)(p.ws + OFF_UV);
  const float* cw = p.fconv_w + (size_t)l * 3 * FFH;
  const float* cb = p.fconv_b + (size_t)l * FFH;
  TileIter ti(bid, nblk, NI, NJ);
  int it, jt;
  while (ti.next(it, jt)) {
    if (it < 0) continue;
    const int t0 = jt * 254 - 1;
    SrcPlain ps{WT + (size_t)it * 256 * D, D};
    SrcHalo qs{(const u16*)(p.ws + OFF_HA), D, t0, NTOK - 1};
    f32x4 acc[8][4];
    gemm_mainloop(ps, qs, D, smem, acc);
    const int tid = ltid(), lane = tid & 63, wave = tid >> 6;
    const int wi = wave >> 2, wj = wave & 3, lr = lane & 15, lq = lane >> 4;
    char* dst = smem + wi * 69632;
#pragma unroll
    for (int n = 0; n < 4; ++n) {
      const int jj = wj * 64 + n * 16 + lr;
#pragma unroll
      for (int m = 0; m < 8; ++m) {
        const int c = m * 16 + lq * 4;
        uint2 o; o.x = pack2(acc[m][n][0], acc[m][n][1]); o.y = pack2(acc[m][n][2], acc[m][n][3]);
        *(uint2*)(dst + jj * 272 + c * 2) = o;
      }
    }
    lds_barrier();
    {
      const int c8 = (tid & 15) * 8;
      const int cg = it * 128 + c8;
      f32x2v w0[4], w1[4], w2[4], bv[4];
#pragma unroll
      for (int q = 0; q < 4; ++q) {
        w0[q] = f32x2v{cw[cg + 2 * q], cw[cg + 2 * q + 1]};
        w1[q] = f32x2v{cw[FFH + cg + 2 * q], cw[FFH + cg + 2 * q + 1]};
        w2[q] = f32x2v{cw[2 * FFH + cg + 2 * q], cw[2 * FFH + cg + 2 * q + 1]};
        bv[q] = f32x2v{cb[cg + 2 * q], cb[cg + 2 * q + 1]};
      }
#pragma unroll 2
      for (int i = 0; i < 8; ++i) {
        const int jj = (tid >> 4) + 32 * i;
        const int t = t0 + jj;
        if (jj >= 1 && jj <= 254 && t < NTOK) {
          uint4 um = *(const uint4*)(smem + (jj - 1) * 272 + c8 * 2);
          const uint4 uc = *(const uint4*)(smem + jj * 272 + c8 * 2);
          uint4 up = *(const uint4*)(smem + (jj + 1) * 272 + c8 * 2);
          const uint4 vv = *(const uint4*)(smem + 69632 + jj * 272 + c8 * 2);
          if ((t & (SEQ - 1)) == 0) um = make_uint4(0u, 0u, 0u, 0u);
          if ((t & (SEQ - 1)) == SEQ - 1) up = make_uint4(0u, 0u, 0u, 0u);
          const unsigned umv[4] = {um.x, um.y, um.z, um.w}, ucv[4] = {uc.x, uc.y, uc.z, uc.w};
          const unsigned upv[4] = {up.x, up.y, up.z, up.w}, vvv[4] = {vv.x, vv.y, vv.z, vv.w};
          unsigned ov[4];
#pragma unroll
          for (int q = 0; q < 4; ++q) {
            const f32x2v u = w0[q] * bfpair(umv[q]) + w1[q] * bfpair(ucv[q]) + w2[q] * bfpair(upv[q]) + bv[q];
            const f32x2v g = gelu2(u) * bfpair(vvv[q]);
            ov[q] = pack2(g.x, g.y);
          }
          nt_store16(gact + (size_t)t * FFH + cg, make_uint4(ov[0], ov[1], ov[2], ov[3]));
        }
      }
    }
  }
  if (l == 0) {
    unsigned* qc = (unsigned*)(p.ws + OFF_CNT) + 17;
    int* sh = (int*)(smem + 140000);
    for (;;) {
      __syncthreads();
      if (ltid() == 0) *sh = (int)atomicAdd(qc, 1u);
      __syncthreads();
      const int id2 = FFN_CONV_FIRST + *sh;
      if (id2 >= FFN_CONV_TOTAL) break;
      ffn_convert_pair(p, id2, smem);
    }
  }
}

PHASE_FN void phase_down(const Params& p, char* smem, int bid, int nblk, int l) {
  constexpr int NI = 4, NJ = NTOK / 256;
  const u16* WT = (const u16*)(p.ws + OFF_WDOWN + l * WDOWN_SZ);
  TileIter ti(bid, nblk, NI, NJ);
  int it, jt;
  while (ti.next(it, jt)) {
    if (it < 0) continue;
    SrcPlain ps{WT + (size_t)it * 256 * FFH, FFH};
    SrcPlain qs{(const u16*)(p.ws + OFF_UV) + (size_t)jt * 256 * FFH, FFH};
    EpiY epi{(u16*)(p.ws + OFF_YBUF), (float*)(p.ws + OFF_SSQ), it * 256, jt * 256, it, nullptr, nullptr};
    gemm_tile<true>(ps, qs, FFH, smem, epi);
  }
}

template <int W>
DEV void pool_task(const u16* h1, u16* pooled, int token, int c8) {
  const int b = token / SEQ, t = token % SEQ;
  const int lo = t - W / 2;
  const u16* base = h1 + (size_t)b * SEQ * D + c8;
  uint4 raw[W];
#pragma unroll
  for (int j = 0; j < W; ++j) {
    const int tt = min(max(lo + j, 0), SEQ - 1);
    raw[j] = *(const uint4*)(base + (size_t)tt * D);
  }
  float s[8];
#pragma unroll
  for (int e = 0; e < 8; ++e) s[e] = 0.f;
  float self[8];
#pragma unroll
  for (int j = 0; j < W; ++j) {
    float v[8];
    unpack8(raw[j], v);
    const bool ok = (unsigned)(lo + j) < (unsigned)SEQ;
#pragma unroll
    for (int e = 0; e < 8; ++e) s[e] += ok ? v[e] : 0.f;
    if (j == W / 2) {
#pragma unroll
      for (int e = 0; e < 8; ++e) self[e] = v[e];
    }
  }
  const int cnt = min(lo + W, SEQ) - max(lo, 0);
  const float inv = __builtin_amdgcn_rcpf((float)cnt);
  float o[8];
#pragma unroll
  for (int e = 0; e < 8; ++e) o[e] = s[e] * inv - self[e];
  *(uint4*)(pooled + (size_t)token * D + c8) = pack8(o);
}

PHASE_FN void phase_pool(const Params& p, int bid, int nblk) {
  const u16* h1 = (const u16*)(p.ws + OFF_HA);
  u16* pooled = (u16*)(p.ws + OFF_POOLED);
  const int lane = ltid() & 63, gw = bid * 8 + (ltid() >> 6), nw = nblk * 8;
  for (int wt = gw; wt < (NTOK / 2) * 4; wt += nw) {
    const int g = wt & 3, tp = wt >> 2;
    const int token = tp * 2 + (lane >> 5);
    const int c8 = (g * 32 + (lane & 31)) * 8;
    if (g == 0) pool_task<2>(h1, pooled, token, c8);
    else if (g == 1) pool_task<4>(h1, pooled, token, c8);
    else if (g == 2) pool_task<8>(h1, pooled, token, c8);
    else pool_task<16>(h1, pooled, token, c8);
  }
}

#if MK_COOP
DEV void grid_barrier(unsigned* cnt, unsigned& target, unsigned nblk) {
  asm volatile("s_waitcnt vmcnt(0)" ::: "memory");
  __syncthreads();
  target += 1;
  if (ltid() == 0) {
    __builtin_amdgcn_fence(__ATOMIC_RELEASE, "agent");
    asm volatile("s_waitcnt vmcnt(0)" ::: "memory");
    const unsigned shard = blockIdx.x & 7u;
    const unsigned per = nblk >> 3;
    const unsigned old = __hip_atomic_fetch_add(cnt + 320 + 64 * shard, 1u, __ATOMIC_RELAXED, __HIP_MEMORY_SCOPE_AGENT);
    if (old + 1u == target * per) __hip_atomic_fetch_add(cnt + 256, 1u, __ATOMIC_RELAXED, __HIP_MEMORY_SCOPE_AGENT);
    while (__hip_atomic_load(cnt + 256, __ATOMIC_RELAXED, __HIP_MEMORY_SCOPE_AGENT) < target * 8u) __builtin_amdgcn_s_sleep(1);
    __builtin_amdgcn_fence(__ATOMIC_ACQUIRE, "agent");
    asm volatile("s_waitcnt vmcnt(0)" ::: "memory");
  }
  __syncthreads();
}

typedef const __attribute__((address_space(4))) Params* KParamPtr;
DEV Params load_params() {
  KParamPtr kp = (KParamPtr)__builtin_amdgcn_kernarg_segment_ptr();
  asm volatile("" : "+s"(kp));
#if defined(__HIP_DEVICE_COMPILE__)
  return *kp;
#else
  return Params{};
#endif
}
#define PH(call) { const Params p = load_params(); call; }
__global__ void __launch_bounds__(512, 2) mega_kernel(Params p_in) {
  __shared__ __attribute__((aligned(16))) char smem[SMEM_BYTES];
  const int bid = blockIdx.x, nblk = gridDim.x;
  if (p_in.ws == nullptr) cg::this_grid().sync();
  unsigned target = 0;
#define GSYNC() { unsigned* cnt_; { const Params p = load_params(); cnt_ = (unsigned*)(p.ws + OFF_CNT); } grid_barrier(cnt_, target, (unsigned)nblk); }
  PH(phase0(p, smem, bid, nblk)); GSYNC();
  PH(phase_norm_in(p, bid, nblk)); GSYNC();
  PH(phase_inproj(p, smem, bid, nblk)); GSYNC();
  PH(phase_conv(p, smem, bid, nblk)); GSYNC();
  PH(phase_mixer(p, smem, bid, nblk)); GSYNC();
  PH(phase_gated(p, smem, bid, nblk)); GSYNC();
  PH(phase_outproj(p, smem, bid, nblk)); GSYNC();
  for (int l = 0; l < 2; ++l) {
    if (l == 1) {
      PH(phase_pool(p, bid, nblk)); GSYNC();
      PH(phase_poolgemm(p, smem, bid, nblk)); GSYNC();
    }
    {
      const Params p = load_params();
      const float* ml = (const float*)(p.ws + OFF_MOD) + (size_t)l * 9 * 6144;
      const float* ng = p.norm_g + (size_t)l * 4096;
      u16* res = (u16*)(p.ws + OFF_RES);
      if (l == 0) phase_row_update<false, true>(p, bid, nblk, p.x, res, ml + 2048, ng + 1024, true, ng + 2048, ml + 3072, ml + 4096);
      else phase_row_update<true, true>(p, bid, nblk, res, res, ml + 2048, ng + 1024, true, ng + 2048, ml + 3072, ml + 4096);
    }
    GSYNC();
    PH(phase_up(p, smem, bid, nblk, l)); GSYNC();
    PH(phase_down(p, smem, bid, nblk, l)); GSYNC();
    {
      const Params p = load_params();
      const float* mod = (const float*)(p.ws + OFF_MOD);
      const float* ml = mod + (size_t)l * 9 * 6144;
      const float* ng = p.norm_g + (size_t)l * 4096;
      u16* res = (u16*)(p.ws + OFF_RES);
      if (l == 0) phase_row_update<true, true>(p, bid, nblk, res, res, ml + 5120, ng + 3072, true, p.norm_g + 4096, mod + 9 * 6144, mod + 9 * 6144 + 1024);
      else phase_row_update<true, false>(p, bid, nblk, res, p.out, ml + 5120, ng + 3072, false, p.norm_g + 4096, mod + 9 * 6144, mod + 9 * 6144 + 1024);
    }
    if (l == 0) GSYNC();
  }
}
#endif

extern "C" void kernel_launch(void* const* d_in, const int* in_sizes, int n_in, void* d_out, int out_size, void* d_ws,
                              size_t ws_size, hipStream_t stream) {
  Params p{};
  const float** f = (const float**)&p;
  for (int i = 0; i < 23; ++i) f[i] = (const float*)d_in[i];
  p.out = (float*)d_out;
  p.ws = (char*)d_ws;
#if MK_COOP
  static int grid_blocks = 0;
  if (!grid_blocks) {
    int dev = 0, cus = 0, per_cu = 0;
    hipGetDevice(&dev);
    hipDeviceGetAttribute(&cus, hipDeviceAttributeMultiprocessorCount, dev);
    hipOccupancyMaxActiveBlocksPerMultiprocessor(&per_cu, mega_kernel, 512, 0);
    if (per_cu > 1) per_cu = 1;
    grid_blocks = cus * per_cu;
  }
  hipMemsetAsync(p.ws + OFF_CNT, 0, 4096, stream);
  void* args[] = {&p};
  hipError_t e = hipLaunchCooperativeKernel((void*)mega_kernel, dim3(grid_blocks), dim3(512), args, 0, stream);
  if (e != hipSuccess) fprintf(stderr, "cooperative launch failed: %s (grid %d)\n", hipGetErrorString(e), grid_blocks);
#endif
}
```
